# Optimizing an MI355X kernel written in HIP

```python
import jax, jax.numpy as jnp
from jax import lax
import numpy as np

D_MODEL = 1024
BATCH = 8
SEQ = 2048
DEPTH = 2

GRID_W = 64
CTX_LEN = 256
RET_HEADS = 4
RET_DIM = 64
RET_W = RET_HEADS * RET_DIM
RET_CHUNK = 128
MLA_HEADS = 8
MLA_NOPE = 64
MLA_ROPE = 32
MLA_V = 64
MLA_Q_RANK = 256
MLA_KV_RANK = 128
MLA_W = MLA_HEADS * MLA_V
POOL_GROUPS = 4
POOL_WINDOWS = (2, 4, 8, 16)
POOL_W = D_MODEL - RET_W - MLA_W
POOL_GDIM = POOL_W // POOL_GROUPS
MIX_W = RET_W + MLA_W + POOL_W
IN_SIZES = (RET_W, RET_W, RET_W, RET_W, MLA_Q_RANK, MLA_KV_RANK, MLA_ROPE, POOL_W)
IN_W = sum(IN_SIZES)
D_FF = 4 * D_MODEL
Q_BLOCK = 128
ROPE_BASE = 10000.0
EPS = 1e-6

kernel_name = "hybrid_retention_mla_pool_dit"


def rmsnorm(x, g):
    xf = x.astype(jnp.float32)
    y = xf * lax.rsqrt(jnp.mean(xf * xf, axis=-1, keepdims=True) + EPS)
    return (y * g.astype(jnp.float32)).astype(x.dtype)


def modulate(h, shift, scale):
    return h * (1.0 + scale) + shift


def head_norm(o):
    of = o.astype(jnp.float32)
    mu = jnp.mean(of, axis=-1, keepdims=True)
    var = jnp.mean(jnp.square(of - mu), axis=-1, keepdims=True)
    return (of - mu) * lax.rsqrt(var + EPS)


def flip(a):
    return jnp.flip(a, axis=1)


def split_proj(p):
    idx, acc = [], 0
    for s in IN_SIZES[:-1]:
        acc += s
        idx.append(acc)
    return jnp.split(p, idx, axis=-1)


def axial_rope_tables(length, dim):
    rows = length // GRID_W
    row = jnp.repeat(jnp.arange(rows), GRID_W).astype(jnp.float32)
    col = jnp.tile(jnp.arange(GRID_W), rows).astype(jnp.float32)
    n_freq = dim // 4
    inv = ROPE_BASE ** (-jnp.arange(n_freq, dtype=jnp.float32) / n_freq)
    ang = jnp.concatenate([row[:, None] * inv, col[:, None] * inv], axis=-1)
    return jnp.cos(ang), jnp.sin(ang)


def apply_rope(x, cos, sin):
    shape = (x.shape[1],) + (1,) * (x.ndim - 3) + (cos.shape[-1],)
    cos = cos.reshape(shape).astype(x.dtype)
    sin = sin.reshape(shape).astype(x.dtype)
    x1, x2 = jnp.split(x, 2, axis=-1)
    return jnp.concatenate([x1 * cos - x2 * sin, x1 * sin + x2 * cos], axis=-1)


def ret_states(k, v, log_g, s0):
    B, L, H, dk = k.shape
    n = L // RET_CHUNK
    kc = k.reshape(B, n, RET_CHUNK, H, dk)
    vc = v.reshape(B, n, RET_CHUNK, H, -1)
    pos = jnp.arange(RET_CHUNK, dtype=jnp.float32)
    w_k = jnp.exp(log_g[:, None] * (RET_CHUNK - 1.0 - pos)[None, :])
    u = jnp.einsum('bnjhd,hj,bnjhe->nbhde', kc, w_k, vc)
    g_chunk = jnp.exp(log_g * RET_CHUNK)[None, :, None, None]

    def step(s, u_c):
        return g_chunk * s + u_c, s

    s_fin, s_start = lax.scan(step, s0, u)
    return jnp.moveaxis(s_start, 0, 1), s_fin


def ret_outputs(q, k, v, log_g, s_start, inclusive):
    B, L, H, dk = q.shape
    n = L // RET_CHUNK
    qc = q.reshape(B, n, RET_CHUNK, H, dk)
    kc = k.reshape(B, n, RET_CHUNK, H, dk)
    vc = v.reshape(B, n, RET_CHUNK, H, -1)
    pos = jnp.arange(RET_CHUNK, dtype=jnp.float32)
    diff = pos[:, None] - pos[None, :]
    mask = (diff >= 0) if inclusive else (diff > 0)
    d_in = jnp.where(mask[None], jnp.exp(log_g[:, None, None] * jnp.where(mask, diff, 0.0)[None]), 0.0)
    s = jnp.einsum('bnihd,bnjhd->bnhij', qc, kc) * d_in
    o = jnp.einsum('bnhij,bnjhe->bnihe', s, vc)
    w_q = jnp.exp(log_g[:, None] * (pos + 1.0)[None, :])
    o = o + jnp.einsum('bnihd,hi,bnhde->bnihe', qc, w_q, s_start)
    return o.reshape(B, L, H, -1)


def retention_bidir(q, k, v, lg, s0_f, s0_b):
    st_f, fin_f = ret_states(k, v, lg[0], s0_f)
    qb, kb, vb = flip(q), flip(k), flip(v)
    st_b, fin_b = ret_states(kb, vb, lg[1], s0_b)
    o = ret_outputs(q, k, v, lg[0], st_f, True) + flip(ret_outputs(qb, kb, vb, lg[1], st_b, False))
    return o, fin_f, fin_b


def retention_out(o, g):
    B, L = o.shape[:2]
    return jax.nn.silu(g) * head_norm(o).reshape(B, L, RET_W).astype(g.dtype)


def mla_q(cq, q_norm, w_uq):
    B, L, _ = cq.shape
    q = (rmsnorm(cq, q_norm) @ w_uq).reshape(B, L, MLA_HEADS, MLA_NOPE + MLA_ROPE)
    return q[..., :MLA_NOPE], q[..., MLA_NOPE:]


def mla_kv(ckv, kv_norm, w_ukv):
    B, L, _ = ckv.shape
    kv = (rmsnorm(ckv, kv_norm) @ w_ukv).reshape(B, L, MLA_HEADS, MLA_NOPE + MLA_V)
    return kv[..., :MLA_NOPE], kv[..., MLA_NOPE:]


def mla_attend(q_nope, q_pe, k_nope, k_pe, v):
    scale = (MLA_NOPE + MLA_ROPE) ** -0.5
    s = (jnp.einsum('bqhd,bkhd->bhqk', q_nope, k_nope)
         + jnp.einsum('bqhr,bkr->bhqk', q_pe, k_pe)) * scale
    p = jax.nn.softmax(s.astype(jnp.float32), axis=-1).astype(v.dtype)
    return jnp.einsum('bhqk,bkhe->bqhe', p, v)


def blocked_attend(q_nope, q_pe, k_nope, k_pe, v):
    B, L, H, _ = q_nope.shape
    nb = L // Q_BLOCK
    qn = jnp.moveaxis(q_nope.reshape(B, nb, Q_BLOCK, H, -1), 1, 0)
    qp = jnp.moveaxis(q_pe.reshape(B, nb, Q_BLOCK, H, -1), 1, 0)
    o = lax.map(lambda a: mla_attend(a[0], a[1], k_nope, k_pe, v), (qn, qp))
    return jnp.moveaxis(o, 0, 1).reshape(B, L, H, -1)


def pool_branch(u, w_pool, pool_scale):
    B, L, C = u.shape
    win = jnp.repeat(jnp.asarray(POOL_WINDOWS, jnp.int32), POOL_GDIM)
    t = jnp.arange(L, dtype=jnp.int32)[:, None]
    lo = jnp.clip(t - win // 2, 0, L)
    hi = jnp.clip(t - win // 2 + win, 0, L)
    cs = jnp.pad(jnp.cumsum(u.astype(jnp.float32), axis=1), ((0, 0), (1, 0), (0, 0)))
    tot = (jnp.take_along_axis(cs, jnp.broadcast_to(hi[None], (B, L, C)), axis=1)
           - jnp.take_along_axis(cs, jnp.broadcast_to(lo[None], (B, L, C)), axis=1))
    pooled = (tot / (hi - lo).astype(jnp.float32) - u.astype(jnp.float32)).astype(u.dtype)
    y = jnp.einsum('blgc,gcd->blgd', pooled.reshape(B, L, POOL_GROUPS, POOL_GDIM), w_pool)
    return y.reshape(B, L, C) * pool_scale


def token_mix(hx, hc, w_in, q_norm, w_uq, kv_norm, w_ukv, decay_logit, w_pool, pool_scale, w_out, need_ctx):
    B, L, _ = hx.shape
    rq_l, rk_l, rv_l, rg_l, cq_l, ckv_l, kpe_l, u_l = split_proj(hx @ w_in)
    rq_c, rk_c, rv_c, rg_c, cq_c, ckv_c, kpe_c, u_c = split_proj(hc @ w_in)

    def ret_heads(a):
        return a.reshape(a.shape[0], a.shape[1], RET_HEADS, RET_DIM)
    k_scale = RET_DIM ** -0.5
    cos_r, sin_r = axial_rope_tables(L, RET_DIM)
    ql = apply_rope(ret_heads(rq_l), cos_r, sin_r)
    kl = apply_rope(ret_heads(rk_l), cos_r, sin_r) * k_scale
    vl = ret_heads(rv_l)
    qc, kc, vc = ret_heads(rq_c), ret_heads(rk_c) * k_scale, ret_heads(rv_c)
    lg = jax.nn.log_sigmoid(decay_logit.astype(jnp.float32))
    s_zero = jnp.zeros((B, RET_HEADS, RET_DIM, RET_DIM), jnp.float32)
    if need_ctx:
        o_rc, fin_f, fin_b = retention_bidir(qc, kc, vc, lg, s_zero, s_zero)
    else:
        _, fin_f = ret_states(kc, vc, lg[0], s_zero)
        _, fin_b = ret_states(flip(kc), flip(vc), lg[1], s_zero)
    o_rl, _, _ = retention_bidir(ql, kl, vl, lg, fin_f, fin_b)
    ret_l = retention_out(o_rl, rg_l)

    cos_m, sin_m = axial_rope_tables(L, MLA_ROPE)
    qn_l, qp_l = mla_q(cq_l, q_norm, w_uq)
    qp_l = apply_rope(qp_l, cos_m, sin_m)
    kn_l, v_l = mla_kv(ckv_l, kv_norm, w_ukv)
    kpe_l = apply_rope(kpe_l, cos_m, sin_m)
    kn_c, v_c = mla_kv(ckv_c, kv_norm, w_ukv)
    kn_all = jnp.concatenate([kn_c, kn_l], axis=1)
    kpe_all = jnp.concatenate([kpe_c, kpe_l], axis=1)
    v_all = jnp.concatenate([v_c, v_l], axis=1)
    mla_l = blocked_attend(qn_l, qp_l, kn_all, kpe_all, v_all).reshape(B, L, MLA_W)

    pool_l = pool_branch(u_l, w_pool, pool_scale)

    out_l = jnp.concatenate([ret_l, mla_l, pool_l], axis=-1) @ w_out
    if not need_ctx:
        return out_l, None
    Lc = hc.shape[1]
    qn_c, qp_c = mla_q(cq_c, q_norm, w_uq)
    mla_c = mla_attend(qn_c, qp_c, kn_c, kpe_c, v_c).reshape(B, Lc, MLA_W)
    out_c = jnp.concatenate([retention_out(o_rc, rg_c), mla_c, pool_branch(u_c, w_pool, pool_scale)], axis=-1) @ w_out
    return out_l, out_c


def sq_relu_mlp(h, w1, w2):
    return jnp.square(jax.nn.relu(h @ w1)) @ w2


def setup_inputs(seed: int = 0) -> dict:
    key = jax.random.key(seed)
    ks = jax.random.split(key, 20)
    f32 = jnp.float32

    def nrm(k, shape, fan_in):
        return jax.random.normal(k, shape, f32) * (fan_in ** -0.5)

    def gain(k, shape):
        return 1.0 + 0.02 * jax.random.normal(k, shape, f32)

    base = 1.0 - 2.0 ** (-5.0 - jnp.arange(RET_HEADS, dtype=f32))
    logit = jnp.log(base) - jnp.log1p(-base)
    ret_decay_logit = jnp.broadcast_to(logit, (DEPTH, 2, RET_HEADS)) + 0.1 * jax.random.normal(ks[12], (DEPTH, 2, RET_HEADS), f32)
    return {
        "x": jax.random.normal(ks[0], (BATCH, SEQ, D_MODEL), f32),
        "c": jax.random.normal(ks[1], (BATCH, D_MODEL), f32),
        "ctx": jax.random.normal(ks[2], (BATCH, CTX_LEN, D_MODEL), f32),
        "c_ctx": jax.random.normal(ks[3], (D_MODEL,), f32),
        "w_ada": nrm(ks[4], (DEPTH, D_MODEL, 6 * D_MODEL), D_MODEL),
        "b_ada": 0.01 * jax.random.normal(ks[5], (DEPTH, 6 * D_MODEL), f32),
        "norm_mix": gain(ks[6], (DEPTH, D_MODEL)),
        "w_in": nrm(ks[7], (DEPTH, D_MODEL, IN_W), D_MODEL),
        "q_norm": gain(ks[8], (DEPTH, MLA_Q_RANK)),
        "w_uq": nrm(ks[9], (DEPTH, MLA_Q_RANK, MLA_HEADS * (MLA_NOPE + MLA_ROPE)), MLA_Q_RANK),
        "kv_norm": gain(ks[10], (DEPTH, MLA_KV_RANK)),
        "w_ukv": nrm(ks[11], (DEPTH, MLA_KV_RANK, MLA_HEADS * (MLA_NOPE + MLA_V)), MLA_KV_RANK),
        "ret_decay_logit": ret_decay_logit,
        "w_pool": nrm(ks[13], (DEPTH, POOL_GROUPS, POOL_GDIM, POOL_GDIM), POOL_GDIM),
        "pool_scale": 1.0 + 0.1 * jax.random.normal(ks[14], (DEPTH, POOL_W), f32),
        "w_out": nrm(ks[15], (DEPTH, MIX_W, D_MODEL), MIX_W),
        "norm_mlp": gain(ks[16], (DEPTH, D_MODEL)),
        "w_ff1": nrm(ks[17], (DEPTH, D_MODEL, D_FF), D_MODEL),
        "w_ff2": nrm(ks[18], (DEPTH, D_FF, D_MODEL), D_FF),
        "norm_final": gain(ks[19], (D_MODEL,)),
    }


def reference(x, c, ctx, c_ctx, w_ada, b_ada, norm_mix, w_in, q_norm, w_uq, kv_norm, w_ukv,
              ret_decay_logit, w_pool, pool_scale, w_out, norm_mlp, w_ff1, w_ff2, norm_final):
    h = ctx
    for l in range(DEPTH):
        last = l == DEPTH - 1
        mod_x = (jax.nn.silu(c) @ w_ada[l] + b_ada[l])[:, None, :]
        mod_c = jax.nn.silu(c_ctx) @ w_ada[l] + b_ada[l]
        sh1, sc1, g1, sh2, sc2, g2 = jnp.split(mod_x, 6, axis=-1)
        csh1, csc1, cg1, csh2, csc2, cg2 = jnp.split(mod_c, 6, axis=-1)

        hx = modulate(rmsnorm(x, norm_mix[l]), sh1, sc1)
        hc = modulate(rmsnorm(h, norm_mix[l]), csh1, csc1)
        ox, oc = token_mix(hx, hc, w_in[l], q_norm[l], w_uq[l], kv_norm[l], w_ukv[l],
                           ret_decay_logit[l], w_pool[l], pool_scale[l], w_out[l], not last)
        x = x + g1 * ox
        x = x + g2 * sq_relu_mlp(modulate(rmsnorm(x, norm_mlp[l]), sh2, sc2), w_ff1[l], w_ff2[l])
        if not last:
            h = h + cg1 * oc
            h = h + cg2 * sq_relu_mlp(modulate(rmsnorm(h, norm_mlp[l]), csh2, csc2), w_ff1[l], w_ff2[l])
    return rmsnorm(x, norm_final)
```

```cpp
#include <hip/hip_runtime.h>
#include <hip/hip_cooperative_groups.h>
#include <cstdio>
#include <cstdint>
namespace cg = cooperative_groups;

#define LAS __attribute__((address_space(3)))
typedef unsigned short bf16_t;
typedef short bf16x8 __attribute__((ext_vector_type(8)));
typedef float f32x4 __attribute__((ext_vector_type(4)));
typedef float f32x16 __attribute__((ext_vector_type(16)));
typedef unsigned u32x4 __attribute__((ext_vector_type(4)));
typedef unsigned u32x2 __attribute__((ext_vector_type(2)));

constexpr int D = 1024, NB = 8, SEQ = 2048, CTX = 256;
constexpr int ML = NB * SEQ;
constexpr int MC = NB * CTX;
constexpr int MT = ML + MC;
constexpr int FF = 4096, INW = 1696, NIN = 1536;
constexpr float EPS = 1e-6f;
constexpr float QSCALE = 0.10206207261596575f * 1.4426950408889634f;

constexpr size_t MiB = 1u << 20;
constexpr size_t WS_WIN = 0;
constexpr size_t WS_WUQ = 7 * MiB;
constexpr size_t WS_WUKV = 8 * MiB;
constexpr size_t WS_WOUT = 9 * MiB;
constexpr size_t WS_WFF1 = 13 * MiB;
constexpr size_t WS_WFF2 = 29 * MiB;
constexpr size_t WS_MOD = 45 * MiB;
constexpr size_t WS_H = 46 * MiB;
constexpr size_t WS_HX = 54 * MiB;
constexpr size_t WS_SSQQ = 90 * MiB;
constexpr size_t WS_SSQK = 90 * MiB + 512 * 1024;
constexpr size_t WS_F = 91 * MiB;
constexpr size_t WS_RQ = 91 * MiB, WS_RK = 100 * MiB, WS_RG = 109 * MiB, WS_CQ = 118 * MiB, WS_U = 127 * MiB, WS_RVT = 136 * MiB;
constexpr size_t WS_CKV = 145 * MiB;
constexpr size_t WS_Q = 154 * MiB;
constexpr size_t WS_KN = 181 * MiB;
constexpr size_t WS_VT = 199 * MiB;
constexpr size_t WS_MIX = 217 * MiB;
constexpr size_t WS_BAR = 253 * MiB;
constexpr size_t WS_END = 254 * MiB;

#ifndef SKIPMASK
#define SKIPMASK 0
#endif
#define RUN(bit) (!((SKIPMASK >> (bit)) & 1))
#ifndef DUPMASK
#define DUPMASK 0
#endif
#define NREP(bit) (1 + ((DUPMASK >> (bit)) & 1))
constexpr int LDS_BYTES = 135168;

__device__ __forceinline__ unsigned cvt_pk_bf16(float lo, float hi) { unsigned r; asm("v_cvt_pk_bf16_f32 %0, %1, %2" : "=v"(r) : "v"(lo), "v"(hi)); return r; }
__device__ __forceinline__ float bf_lo(unsigned u) { return __uint_as_float(u << 16); }
__device__ __forceinline__ float bf_hi(unsigned u) { return __uint_as_float(u & 0xffff0000u); }
__device__ __forceinline__ int fresh_bx() { int b = blockIdx.x; asm volatile("" : "+s"(b)); return b; }
__device__ __forceinline__ int fresh_lane() { int l; asm volatile("v_mbcnt_lo_u32_b32 %0, -1, 0\n\tv_mbcnt_hi_u32_b32 %0, -1, %0" : "=v"(l)); return l; }
__device__ __forceinline__ float xsum32(float v) { auto r = __builtin_amdgcn_permlane32_swap(__float_as_uint(v), __float_as_uint(v), false, false); return __uint_as_float(r[0]) + __uint_as_float(r[1]); }
__device__ __forceinline__ float xmax32(float v) { auto r = __builtin_amdgcn_permlane32_swap(__float_as_uint(v), __float_as_uint(v), false, false); return fmaxf(__uint_as_float(r[0]), __uint_as_float(r[1])); }
__device__ __forceinline__ float xsum16(float v) { auto r = __builtin_amdgcn_permlane16_swap(__float_as_uint(v), __float_as_uint(v), false, false); return __uint_as_float(r[0]) + __uint_as_float(r[1]); }
__device__ __forceinline__ float dppf(float v, int ctrl_sel) {
    const int x = __float_as_int(v); int r;
    if (ctrl_sel == 0) r = __builtin_amdgcn_update_dpp(0, x, 0xB1, 0xF, 0xF, false);
    else if (ctrl_sel == 1) r = __builtin_amdgcn_update_dpp(0, x, 0x4E, 0xF, 0xF, false);
    else if (ctrl_sel == 2) r = __builtin_amdgcn_update_dpp(0, x, 0x141, 0xF, 0xF, false);
    else r = __builtin_amdgcn_update_dpp(0, x, 0x140, 0xF, 0xF, false);
    return __int_as_float(r);
}
__device__ __forceinline__ float wave_sum(float v) {
    v += dppf(v, 0); v += dppf(v, 1); v += dppf(v, 2); v += dppf(v, 3);
    v = xsum16(v); v = xsum32(v);
    return v;
}
__device__ __forceinline__ u32x4 gld16(const void* p) { return *(const __attribute__((address_space(1))) u32x4*)p; }
__device__ __forceinline__ float fexp2(float x) { return __builtin_amdgcn_exp2f(x); }

namespace pg8 {
constexpr int BM = 256, BK = 64, HALF = 128, HTB = HALF * BK * 2, STAGE_BYTES = 8 * HTB, NXCD = 8, WGM = 8;
__host__ __device__ __forceinline__ int lds_byte(int r, int c) { const int st = (r >> 4) * 2 + (c >> 5), rr = r & 15, cc = c & 31, ob = rr * 64 + cc * 2; return st * 1024 + (ob ^ (((ob >> 9) & 1) << 5)); }
__host__ __device__ __forceinline__ void stage_rc(int b, int& R, int& C) { const int st = b / 1024, sb = b % 1024, swz = sb ^ (((sb >> 9) & 1) << 5); R = (st >> 1) * 16 + swz / 64; C = (st & 1) * 32 + (swz % 64) / 2; }
__host__ __device__ __forceinline__ int perm32(int rho) { const int n = rho >> 4, i = rho & 15; return 8 * (i >> 2) + 4 * n + (i & 3); }

struct Unit { int pm, pn; };
struct Gemm { const bf16_t* A; const bf16_t* Bt; int lda, ldb, K; };

struct StaticOrder {
    int nM, nN, nwg, G, c;
    __device__ void init(int M, int N, int G_, int c_) { nM = M / BM; nN = N / BM; nwg = nM * nN; G = G_; c = c_; }
    __device__ bool next(int i, Unit& u) const {
        const long L = (long)i * G + c; if (L >= nwg) return false;
        int wgid = (int)L; { const int q = nwg / NXCD, r = nwg % NXCD, xcd = wgid % NXCD, off = wgid / NXCD; wgid = (xcd < r ? xcd * (q + 1) : r * (q + 1) + (xcd - r) * q) + off; }
        const int nig = WGM * nN, gid = wgid / nig, fm = gid * WGM, gsz = (nM - fm) < WGM ? (nM - fm) : WGM;
        u.pm = fm + ((wgid % nig) % gsz); u.pn = (wgid % nig) / gsz; return true;
    }
};

template <class Epi, bool ALIGN_EPI>
__device__ __forceinline__ void gemm_phase(LAS unsigned char* lds, const Gemm g, const StaticOrder& S, const Epi& E, int wid) {
    const int lane = fresh_lane(), tid = wid * 64 + lane, wr = wid >> 2, wc = wid & 3, fr = lane & 15, fq = lane >> 4;
    int K_ = g.K; if constexpr (Epi::OPAQUE_K) asm volatile("" : "+s"(K_));
    const int K = K_, nt = K / BK;
    unsigned voffA[2], voffB[2];
#pragma unroll
    for (int i = 0; i < 2; ++i) { int R, C; stage_rc(tid * 16 + i * 8192, R, C); const int Rb = Epi::PERM ? ((R & ~31) + perm32(R & 31)) : R;
        voffA[i] = (unsigned)(R * g.lda + C) * 2u; voffB[i] = (unsigned)(Rb * g.ldb + C) * 2u; }
    const size_t kstep = (size_t)(BK * 2);
    const size_t hstepA = (size_t)HALF * g.lda * 2, hstepB = (size_t)HALF * g.ldb * 2;
    const size_t tstepA = 2 * hstepA, tstepB = 2 * hstepB;
    const unsigned ldsw = (unsigned)wid * 1024u;
    const int aoff = lds_byte(wr * 64 + fr, fq * 8), boff = lds_byte(wc * 32 + fr, fq * 8);
#define PG8_SA(b, h) (((b) * 2 + (h)) * HTB)
#define PG8_SB(b, h) ((4 + (b) * 2 + (h)) * HTB)
#define PG8_STAGE(bufoff, gbase, voff) do { _Pragma("unroll") for (int _i = 0; _i < 2; ++_i) \
        __builtin_amdgcn_global_load_lds((const unsigned*)((const char*)(gbase) + (voff)[_i]), (LAS unsigned*)(lds + (bufoff) + ldsw + _i * 8192), 16, 0, 0); } while (0)
#define PG8_LDA(dst, b, h) do { _Pragma("unroll") for (int m = 0; m < 4; ++m) _Pragma("unroll") for (int k = 0; k < 2; ++k) dst[m][k] = *(const LAS bf16x8*)(lds + PG8_SA(b, h) + aoff + m * 2048 + k * 1024); } while (0)
#define PG8_LDB(dst, b, h) do { _Pragma("unroll") for (int n = 0; n < 2; ++n) _Pragma("unroll") for (int k = 0; k < 2; ++k) dst[n][k] = *(const LAS bf16x8*)(lds + PG8_SB(b, h) + boff + n * 2048 + k * 1024); } while (0)
#define PG8_MMA(ai, bj, At, Bt) do { __builtin_amdgcn_s_setprio(1); _Pragma("unroll") for (int m = 0; m < 4; ++m) _Pragma("unroll") for (int n = 0; n < 2; ++n) _Pragma("unroll") for (int k = 0; k < 2; ++k) \
        acc[ai][bj][m][n] = __builtin_amdgcn_mfma_f32_16x16x32_bf16(Bt[n][k], At[m][k], acc[ai][bj][m][n], 0, 0, 0); __builtin_amdgcn_s_setprio(0); } while (0)
#define PG8_WAIT_V(n) asm volatile("s_waitcnt vmcnt(" #n ")" ::: "memory")
#define PG8_WAIT_L(n) asm volatile("s_waitcnt lgkmcnt(" #n ")" ::: "memory")
#define PG8_BAR __builtin_amdgcn_s_barrier()
#define PG8_SCHED __builtin_amdgcn_sched_barrier(0)
    Unit cur, nxt; int ui = 0;
    if (!S.next(0, cur)) return;
    f32x4 acc[2][2][4][2];
#pragma unroll
    for (int a = 0; a < 2; ++a)
#pragma unroll
        for (int b = 0; b < 2; ++b)
#pragma unroll
            for (int m = 0; m < 4; ++m)
#pragma unroll
                for (int n = 0; n < 2; ++n) acc[a][b][m][n] = (f32x4){0.f, 0.f, 0.f, 0.f};
    bf16x8 At[4][2], B0[2][2], B1[2][2];
    const char* cA = (const char*)g.A + (size_t)cur.pm * tstepA; const char* cB = (const char*)g.Bt + (size_t)cur.pn * tstepB;
    PG8_STAGE(PG8_SB(0, 0), cB, voffB); PG8_STAGE(PG8_SB(0, 1), cB + hstepB, voffB); PG8_STAGE(PG8_SA(0, 0), cA, voffA); PG8_STAGE(PG8_SA(0, 1), cA + hstepA, voffA);
    if (wr == 1) PG8_BAR;
    PG8_WAIT_V(2); PG8_BAR;
    PG8_STAGE(PG8_SB(1, 0), cB + kstep, voffB); PG8_STAGE(PG8_SA(1, 0), cA + kstep, voffA); PG8_STAGE(PG8_SB(1, 1), cB + hstepB + kstep, voffB);
    PG8_WAIT_V(6); PG8_BAR;
    for (;;) {
        const bool has_next = S.next(ui + 1, nxt);
        const char* nA = has_next ? (const char*)g.A + (size_t)nxt.pm * tstepA : cA; const char* nB = has_next ? (const char*)g.Bt + (size_t)nxt.pn * tstepB : cB;
        for (int t = 0; t < nt; t += 2) {
            const bool last = (t == nt - 2);
            const char* a1 = cA + (size_t)(t + 1) * kstep;
            const char* a2 = last ? nA : cA + (size_t)(t + 2) * kstep; const char* b2 = last ? nB : cB + (size_t)(t + 2) * kstep;
            const char* a3 = a2 + kstep; const char* b3 = b2 + kstep;
            PG8_LDB(B0, 0, 0); PG8_LDB(B1, 0, 1); PG8_SCHED; PG8_LDA(At, 0, 0); PG8_STAGE(PG8_SA(1, 1), a1 + hstepA, voffA);
            PG8_WAIT_V(8); PG8_WAIT_L(0); PG8_BAR; PG8_MMA(0, 0, At, B0); PG8_MMA(0, 1, At, B1); PG8_BAR; PG8_SCHED;
            PG8_LDA(At, 0, 1); PG8_STAGE(PG8_SB(0, 0), b2, voffB); PG8_STAGE(PG8_SB(0, 1), b2 + hstepB, voffB); PG8_STAGE(PG8_SA(0, 0), a2, voffA);
            PG8_WAIT_V(8); PG8_WAIT_L(0); PG8_BAR; PG8_MMA(1, 0, At, B0); PG8_MMA(1, 1, At, B1); PG8_BAR; PG8_SCHED;
            PG8_LDB(B0, 1, 0); PG8_LDB(B1, 1, 1); PG8_SCHED; PG8_LDA(At, 1, 0); PG8_STAGE(PG8_SA(0, 1), a2 + hstepA, voffA);
            PG8_WAIT_V(8); PG8_WAIT_L(0); PG8_BAR; PG8_MMA(0, 0, At, B0); PG8_MMA(0, 1, At, B1); PG8_BAR; PG8_SCHED;
            PG8_LDA(At, 1, 1); PG8_STAGE(PG8_SB(1, 0), b3, voffB); PG8_STAGE(PG8_SB(1, 1), b3 + hstepB, voffB); PG8_STAGE(PG8_SA(1, 0), a3, voffA);
            PG8_WAIT_V(8); PG8_WAIT_L(0); PG8_BAR; PG8_MMA(1, 0, At, B0); PG8_MMA(1, 1, At, B1); PG8_BAR; PG8_SCHED;
        }
        if constexpr (ALIGN_EPI) { if (wr == 0) PG8_BAR; }
        E(acc, cur, wr, wc, fr, fq);
        if (!has_next) break;
#pragma unroll
        for (int a = 0; a < 2; ++a)
#pragma unroll
            for (int b = 0; b < 2; ++b)
#pragma unroll
                for (int m = 0; m < 4; ++m)
#pragma unroll
                    for (int n = 0; n < 2; ++n) acc[a][b][m][n] = (f32x4){0.f, 0.f, 0.f, 0.f};
        cur = nxt; cA = nA; cB = nB; ++ui;
        if constexpr (ALIGN_EPI) { if (wr == 1) PG8_BAR; }
    }
    PG8_WAIT_V(0);
    if constexpr (!ALIGN_EPI) { if (wr == 0) PG8_BAR; }
    PG8_BAR;
#undef PG8_SA
#undef PG8_SB
#undef PG8_STAGE
#undef PG8_LDA
#undef PG8_LDB
#undef PG8_MMA
#undef PG8_WAIT_V
#undef PG8_WAIT_L
#undef PG8_BAR
#undef PG8_SCHED
}
}

enum { EP_IN = 0, EP_RVT, EP_UPQ, EP_UPK, EP_VT, EP_OUT, EP_FF1, EP_FF2, EP_OUTA, EP_FF2A };

__device__ __forceinline__ void rope8(float (&v)[8], int i0, int half, float invstep, int t) {
    const bool col = i0 >= half; const float pos = (float)(col ? (t & 63) : (t >> 6)); const int j0 = col ? i0 - half : i0;
#pragma unroll
    for (int p = 0; p < 4; ++p) {
        const float inv = fexp2(-(float)(j0 + p) * invstep); const float ang = pos * inv;
        const float s = __sinf(ang), c = __cosf(ang);
        const float x1 = v[2 * p], x2 = v[2 * p + 1];
        v[2 * p] = x1 * c - x2 * s; v[2 * p + 1] = x1 * s + x2 * c;
    }
}
constexpr float L2_10000 = 13.287712379549449f;

struct EpiArgs {
    bf16_t *o0, *o1, *o2, *o3, *o4, *o5;
    float *ssq_q, *ssq_k;
    const float* xin_lat; const float* xin_ctx; float* xout_lat; float* xout_ctx;
    const float* mod;
    int row_off;
};

template <int MODE> struct Epi {
    static constexpr bool F32OUT = (MODE == EP_OUT || MODE == EP_FF2 || MODE == EP_OUTA || MODE == EP_FF2A);
    static constexpr bool PERM = !F32OUT;
    static constexpr bool OPAQUE_K = (MODE == EP_OUTA);
    EpiArgs a;
    __device__ __forceinline__ void operator()(const f32x4 (&acc)[2][2][4][2], const pg8::Unit& u, int wr, int wc, int fr_, int fq_) const {
        const int lane_e = fresh_lane(), fr = lane_e & 15, fq = lane_e >> 4;
        if constexpr (F32OUT) {
            constexpr bool PART = (MODE == EP_OUTA || MODE == EP_FF2A);
            const int goff = (MODE == EP_OUT || MODE == EP_OUTA) ? 2048 : 5120;
            const int row0 = a.row_off + u.pm * 256 + wr * 64 + fr;
            const bool lat = row0 < ML;
            const float* gm = a.mod + (size_t)(lat ? (row0 >> 11) : 8) * 6144 + goff + u.pn * 256 + wc * 32 + fq * 4;
            const size_t rbase = (size_t)(lat ? row0 : row0 - ML) * D + u.pn * 256 + wc * 32 + fq * 4;
            const float* xi = (lat ? a.xin_lat : a.xin_ctx) + rbase;
            float* xo = (lat ? a.xout_lat : a.xout_ctx) + rbase;
            f32x4 gv[2][2];
#pragma unroll
            for (int bj = 0; bj < 2; ++bj)
#pragma unroll
                for (int n = 0; n < 2; ++n) gv[bj][n] = *(const f32x4*)(gm + bj * 128 + n * 16);
            if constexpr (PART) {
#pragma unroll
                for (int ai = 0; ai < 2; ++ai)
#pragma unroll
                    for (int m = 0; m < 4; ++m)
#pragma unroll
                        for (int bj = 0; bj < 2; ++bj)
#pragma unroll
                            for (int n = 0; n < 2; ++n) *(f32x4*)(xo + (size_t)(ai * 128 + m * 16) * D + bj * 128 + n * 16) = gv[bj][n] * acc[ai][bj][m][n];
            } else {
                f32x4 xv[3][2][2];
#pragma unroll
                for (int p = 0; p < 2; ++p)
#pragma unroll
                    for (int bj = 0; bj < 2; ++bj)
#pragma unroll
                        for (int n = 0; n < 2; ++n) xv[p][bj][n] = *(const f32x4*)(xi + (size_t)((p >> 2) * 128 + (p & 3) * 16) * D + bj * 128 + n * 16);
#pragma unroll
                for (int r = 0; r < 8; ++r) {
                    const int ai = r >> 2, m = r & 3;
                    if (r + 2 < 8) {
                        const int r2 = r + 2;
#pragma unroll
                        for (int bj = 0; bj < 2; ++bj)
#pragma unroll
                            for (int n = 0; n < 2; ++n) xv[r2 % 3][bj][n] = *(const f32x4*)(xi + (size_t)((r2 >> 2) * 128 + (r2 & 3) * 16) * D + bj * 128 + n * 16);
                    }
#pragma unroll
                    for (int bj = 0; bj < 2; ++bj)
#pragma unroll
                        for (int n = 0; n < 2; ++n) *(f32x4*)(xo + (size_t)(ai * 128 + m * 16) * D + bj * 128 + n * 16) = xv[r % 3][bj][n] + gv[bj][n] * acc[ai][bj][m][n];
                }
            }
        } else if constexpr (MODE == EP_IN) {
            switch (u.pn) {
                case 0: rows<0>(acc, u, wr, wc, fr, fq); break;
                case 1: rows<1>(acc, u, wr, wc, fr, fq); break;
                case 2: rows<2>(acc, u, wr, wc, fr, fq); break;
                case 3: rows<3>(acc, u, wr, wc, fr, fq); break;
                case 4: rows<4>(acc, u, wr, wc, fr, fq); break;
                default: rows<5>(acc, u, wr, wc, fr, fq); break;
            }
        } else {
            rows<0>(acc, u, wr, wc, fr, fq);
        }
    }
    template <int PN>
    __device__ __forceinline__ void rows(const f32x4 (&acc)[2][2][4][2], const pg8::Unit& u, int wr, int wc, int fr, int fq) const {
        float rcol[2][8];
        if constexpr (MODE == EP_VT) {
#pragma unroll
            for (int bj = 0; bj < 2; ++bj)
#pragma unroll
                for (int e = 0; e < 8; ++e) { const int col = u.pn * 256 + bj * 128 + wc * 32 + fq * 8 + e; const f32x4 s4 = *(const f32x4*)(a.ssq_k + (size_t)col * 4); rcol[bj][e] = rsqrtf(((s4[0] + s4[1]) + (s4[2] + s4[3])) * (1.f / 128.f) + EPS); }
            __builtin_amdgcn_sched_barrier(0);
        }
        float rsr[2][4];
        if constexpr (MODE == EP_UPQ || MODE == EP_UPK) {
            const float* sp = (MODE == EP_UPQ) ? a.ssq_q : a.ssq_k;
            f32x4 s4[2][4];
#pragma unroll
            for (int ai = 0; ai < 2; ++ai)
#pragma unroll
                for (int m = 0; m < 4; ++m) s4[ai][m] = *(const f32x4*)(sp + (size_t)(u.pm * 256 + ai * 128 + wr * 64 + m * 16 + fr) * 4);
#pragma unroll
            for (int ai = 0; ai < 2; ++ai)
#pragma unroll
                for (int m = 0; m < 4; ++m) {
                    const float sm = (s4[ai][m][0] + s4[ai][m][1]) + (s4[ai][m][2] + s4[ai][m][3]);
                    rsr[ai][m] = (MODE == EP_UPQ) ? rsqrtf(sm * (1.f / 256.f) + EPS) * QSCALE : rsqrtf(sm * (1.f / 128.f) + EPS);
                }
            __builtin_amdgcn_sched_barrier(0);
        }
#pragma unroll
        for (int ai = 0; ai < 2; ++ai)
#pragma unroll
            for (int m = 0; m < 4; ++m) {
                const int row = u.pm * 256 + ai * 128 + wr * 64 + m * 16 + fr;
                const bool lat = row < ML; const int t = row & 2047;
                float ssq = 0.f; float rs = 1.f;
                if constexpr (MODE == EP_UPQ || MODE == EP_UPK) rs = rsr[ai][m];
#pragma unroll
                for (int bj = 0; bj < 2; ++bj) {
                    const int cl = bj * 128 + wc * 32 + fq * 8;
                    const int col = u.pn * 256 + cl;
                    float v[8];
#pragma unroll
                    for (int e = 0; e < 4; ++e) { v[e] = acc[ai][bj][m][0][e]; v[4 + e] = acc[ai][bj][m][1][e]; }
                    bf16_t* dst = nullptr;
                    if constexpr (MODE == EP_IN) {
                        if constexpr (PN <= 1) {
                            if (lat) rope8(v, (cl & 63) >> 1, 16, L2_10000 / 16.f, t);
                            if constexpr (PN == 1) {
#pragma unroll
                                for (int e = 0; e < 8; ++e) v[e] *= 0.125f;
                            }
                            dst = (PN == 0 ? a.o0 : a.o1) + (size_t)row * 256 + cl;
                        } else if constexpr (PN == 2) {
#pragma unroll
                            for (int e = 0; e < 8; ++e) v[e] = v[e] / (1.f + __expf(-v[e]));
                            dst = a.o2 + (size_t)row * 256 + cl;
                        } else if constexpr (PN == 3) {
#pragma unroll
                            for (int e = 0; e < 8; ++e) ssq += v[e] * v[e];
                            dst = a.o3 + (size_t)row * 256 + cl;
                        } else if constexpr (PN == 4) {
                            dst = a.o4 + (size_t)row * 256 + cl;
                        } else {
                            if (bj == 0) {
#pragma unroll
                                for (int e = 0; e < 8; ++e) ssq += v[e] * v[e];
                            } else if (cl < 160) { if (lat) rope8(v, (cl - 128) >> 1, 8, L2_10000 / 8.f, t); }
                            dst = a.o5 + (size_t)row * 256 + cl;
                        }
                    } else if constexpr (MODE == EP_RVT) {
                        dst = a.o0 + (size_t)row * MT + col;
                    } else if constexpr (MODE == EP_UPQ) {
                        const int jj = col % 96;
                        if (jj >= 64 && lat) rope8(v, (jj - 64) >> 1, 8, L2_10000 / 8.f, t);
#pragma unroll
                        for (int e = 0; e < 8; ++e) v[e] *= rs;
                        dst = a.o0 + (size_t)row * 768 + col;
                    } else if constexpr (MODE == EP_UPK) {
#pragma unroll
                        for (int e = 0; e < 8; ++e) v[e] *= rs;
                        dst = a.o0 + (size_t)row * 512 + col;
                    } else if constexpr (MODE == EP_VT) {
#pragma unroll
                        for (int e = 0; e < 8; ++e) v[e] *= rcol[bj][e];
                        dst = a.o0 + (size_t)row * MT + col;
                    } else if constexpr (MODE == EP_FF1) {
#pragma unroll
                        for (int e = 0; e < 8; ++e) { const float r = fmaxf(v[e], 0.f); v[e] = r * r; }
                        dst = a.o0 + (size_t)row * FF + col;
                    }
                    u32x4 w; w.x = cvt_pk_bf16(v[0], v[1]); w.y = cvt_pk_bf16(v[2], v[3]); w.z = cvt_pk_bf16(v[4], v[5]); w.w = cvt_pk_bf16(v[6], v[7]);
                    *(u32x4*)dst = w;
                }
                if constexpr (MODE == EP_IN && (PN == 3 || PN == 5)) {
                    ssq = xsum16(ssq); ssq = xsum32(ssq);
                    if (fq == 0) (PN == 3 ? a.ssq_q : a.ssq_k)[(size_t)row * 4 + wc] = ssq;
                }
                __builtin_amdgcn_sched_barrier(0);
            }
    }
};

template <class RowMap>
__device__ __forceinline__ void transpose_item(const float* W, int N, bf16_t* WT, int ldt, const float* kscale, LAS float* scr, int item, int lane, RowMap rm) {
    const int nblk = N / 32, kb = item / nblk, nb = item % nblk, k0 = 64 * kb, n0 = 32 * nb;
#pragma unroll
    for (int i = 0; i < 32; ++i) { const int kk = 2 * i + (lane >> 5); float w = *(const __attribute__((address_space(1))) float*)(W + (size_t)(k0 + kk) * N + n0 + (lane & 31)); if (kscale) w *= kscale[k0 + kk]; scr[kk * 33 + (lane & 31)] = w; }
    asm volatile("s_waitcnt lgkmcnt(0)" ::: "memory");
    const int c = lane & 7;
#pragma unroll
    for (int j = 0; j < 4; ++j) { const int n = (lane >> 3) + 8 * j; const LAS float* s = scr + (8 * c) * 33 + n;
        u32x4 o; o.x = cvt_pk_bf16(s[0 * 33], s[1 * 33]); o.y = cvt_pk_bf16(s[2 * 33], s[3 * 33]); o.z = cvt_pk_bf16(s[4 * 33], s[5 * 33]); o.w = cvt_pk_bf16(s[6 * 33], s[7 * 33]);
        *(u32x4*)(WT + (size_t)rm(n0 + n) * ldt + k0 + 8 * c) = o; }
    asm volatile("s_waitcnt lgkmcnt(0)" ::: "memory");
}
struct MapId { __device__ __forceinline__ int operator()(int n) const { return n; } };
struct MapIn { __device__ __forceinline__ int operator()(int n) const {
    if (n < 512) { const int i = n & 63; return (n & ~63) + (i < 32 ? 2 * i : 2 * (i - 32) + 1); }
    if (n < 768) return 1536 + (n - 512);
    if (n < 1024) return 512 + (n - 768);
    if (n < 1280) return 768 + (n - 1024);
    if (n < 1408) return 1280 + (n - 1280);
    if (n < 1440) { const int i = n - 1408; return 1408 + (i < 16 ? 2 * i : 2 * (i - 16) + 1); }
    return 1024 + (n - 1440);
} };
struct MapUq { __device__ __forceinline__ int operator()(int n) const { const int h = n / 96, j = n - h * 96; if (j < 64) return n; const int r = j - 64; return h * 96 + 64 + (r < 16 ? 2 * r : 2 * (r - 16) + 1); } };
struct MapUkv { __device__ __forceinline__ int operator()(int n) const { const int h = n >> 7, j = n & 127; return j < 64 ? h * 64 + j : 512 + h * 64 + (j - 64); } };


struct TItem { const float* W; bf16_t* WT; const float* kscale; int N, ldt, map, r; };
__device__ __forceinline__ int map_row(int map, int n) {
    if (map == 1) return MapIn()(n);
    if (map == 2) return MapUq()(n);
    if (map == 3) return MapUkv()(n);
    return n;
}
__device__ __forceinline__ void titem_issue(const TItem& t, float (&reg)[32], int lane) {
    const int nblk = t.N / 32, kb = t.r / nblk, nb = t.r - kb * nblk, k0 = 64 * kb, n0 = 32 * nb;
    const float* p = t.W + (size_t)(k0 + (lane >> 5)) * t.N + n0 + (lane & 31);
    const size_t step = (size_t)2 * t.N;
#pragma unroll
    for (int i = 0; i < 32; ++i) { reg[i] = *(const __attribute__((address_space(1))) float*)p; p += step; if ((i & 7) == 7) __builtin_amdgcn_sched_barrier(0); }
}
__device__ __forceinline__ void titem_finish(const TItem& t, const float (&reg)[32], LAS float* scr, int lane) {
    const int nblk = t.N / 32, kb = t.r / nblk, nb = t.r - kb * nblk, k0 = 64 * kb, n0 = 32 * nb;
#pragma unroll
    for (int i = 0; i < 32; ++i) { const int kk = 2 * i + (lane >> 5); scr[kk * 33 + (lane & 31)] = reg[i]; }
    asm volatile("s_waitcnt lgkmcnt(0)" ::: "memory");
    const int c = lane & 7;
    f32x4 ks0 = (f32x4){1.f, 1.f, 1.f, 1.f}, ks1 = ks0;
    if (t.kscale) { ks0 = *(const f32x4*)(t.kscale + k0 + 8 * c); ks1 = *(const f32x4*)(t.kscale + k0 + 8 * c + 4); }
#pragma unroll
    for (int j = 0; j < 4; ++j) { const int n = (lane >> 3) + 8 * j; const LAS float* sp = scr + (8 * c) * 33 + n;
        u32x4 o; o.x = cvt_pk_bf16(sp[0 * 33] * ks0[0], sp[1 * 33] * ks0[1]); o.y = cvt_pk_bf16(sp[2 * 33] * ks0[2], sp[3 * 33] * ks0[3]);
        o.z = cvt_pk_bf16(sp[4 * 33] * ks1[0], sp[5 * 33] * ks1[1]); o.w = cvt_pk_bf16(sp[6 * 33] * ks1[2], sp[7 * 33] * ks1[3]);
        *(u32x4*)(t.WT + (size_t)map_row(t.map, n0 + n) * t.ldt + k0 + 8 * c) = o; }
    asm volatile("s_waitcnt lgkmcnt(0)" ::: "memory");
}

struct Params { const float* in[20]; float* out; unsigned char* ws; };

typedef const __attribute__((address_space(4))) unsigned long long* kaptr_t;
__device__ __forceinline__ unsigned long long karg_raw(int i) { kaptr_t ka = (kaptr_t)__builtin_amdgcn_kernarg_segment_ptr(); asm volatile("" : "+s"(ka)); return ka[i]; }
__device__ __forceinline__ const float* karg(int i) { return (const float*)karg_raw(i); }
__device__ __forceinline__ float* karg_out() { return (float*)karg_raw(20); }
__device__ __forceinline__ unsigned char* karg_ws() { return (unsigned char*)karg_raw(21); }

__device__ __forceinline__ void prologue(LAS unsigned char* lds, int tid, int wave, int lane, int G) {
    unsigned char* ws = karg_ws();
    const float* c_in = karg(1); const float* cctx = karg(3); const float* w_ada = karg(4); const float* b_ada = karg(5);
    if (blockIdx.x < 192) {
        const int l = blockIdx.x / 96, cb = blockIdx.x % 96;
        LAS float* sv = (LAS float*)lds;
        LAS float* red = (LAS float*)(lds + 40960);
        {
            float cv[18];
#pragma unroll
            for (int j = 0; j < 18; ++j) { const int i = tid + j * 512; cv[j] = *(const __attribute__((address_space(1))) float*)(i < 8192 ? c_in + i : cctx + (i - 8192)); }
#pragma unroll
            for (int j = 0; j < 18; ++j) sv[tid + j * 512] = cv[j] / (1.f + __expf(-cv[j]));
        }
        __syncthreads();
        float acc[9];
#pragma unroll
        for (int r = 0; r < 9; ++r) acc[r] = 0.f;
        const float* wp = w_ada + (size_t)l * 1024 * 6144 + cb * 64 + lane;
        const int k0 = wave * 128;
#pragma unroll 32
        for (int k = 0; k < 128; ++k) {
            const float wv = *(const __attribute__((address_space(1))) float*)(wp + (size_t)(k0 + k) * 6144);
#pragma unroll
            for (int r = 0; r < 9; ++r) acc[r] += sv[r * 1024 + k0 + k] * wv;
        }
#pragma unroll
        for (int r = 0; r < 9; ++r) red[(wave * 9 + r) * 64 + lane] = acc[r];
        __syncthreads();
        for (int i = tid; i < 576; i += 512) {
            const int r = i >> 6, ln = i & 63; float s = 0.f;
#pragma unroll
            for (int w = 0; w < 8; ++w) s += red[(w * 9 + r) * 64 + ln];
            const int n = cb * 64 + ln;
            ((float*)(ws + WS_MOD))[(size_t)(l * 9 + r) * 6144 + n] = s + b_ada[l * 6144 + n];
        }
        __syncthreads();
    }
    { const f32x4* src = (const f32x4*)karg(2); f32x4* dst = (f32x4*)(ws + WS_H); for (int i = blockIdx.x * 512 + tid; i < MC * D / 4; i += G * 512) dst[i] = src[i]; }
    LAS float* scr = (LAS float*)(lds + wave * 16384);
    const int gw = blockIdx.x * 8 + wave, NGW = G * 8;
    constexpr int I_IN = 16 * 53, I_UQ = 4 * 24, I_UKV = 2 * 32, I_OUT = 12 * 32, I_F1 = 16 * 128, I_F2 = 64 * 32, I_POOL = 512, I_ZERO = 8;
    constexpr int I_LAYER = I_IN + I_UQ + I_UKV + I_OUT + I_F1 + I_F2 + I_POOL + I_ZERO;
#define DECODE_T(it_, t_, ok_) do { ok_ = false; if ((it_) < 2 * I_LAYER) { const int l_ = (it_) / I_LAYER; int r_ = (it_) - l_ * I_LAYER; \
        if (r_ < I_IN) { t_ = TItem{karg(7) + (size_t)l_ * 1024 * INW, (bf16_t*)(ws + WS_WIN) + (size_t)l_ * 1792 * 1024, nullptr, INW, 1024, 1, r_}; ok_ = true; } \
        else if ((r_ -= I_IN) < I_UQ) { t_ = TItem{karg(9) + (size_t)l_ * 256 * 768, (bf16_t*)(ws + WS_WUQ) + (size_t)l_ * 768 * 256, karg(8) + l_ * 256, 768, 256, 2, r_}; ok_ = true; } \
        else if ((r_ -= I_UQ) < I_UKV) { t_ = TItem{karg(11) + (size_t)l_ * 128 * 1024, (bf16_t*)(ws + WS_WUKV) + (size_t)l_ * 1024 * 256, karg(10) + l_ * 128, 1024, 256, 3, r_}; ok_ = true; } \
        else if ((r_ -= I_UKV) < I_OUT) { t_ = TItem{karg(15) + (size_t)l_ * 1024 * 1024, (bf16_t*)(ws + WS_WOUT) + (size_t)l_ * 1024 * 1024, nullptr, 1024, 1024, 0, r_}; ok_ = true; } \
        else if ((r_ -= I_OUT) < I_F1) { t_ = TItem{karg(17) + (size_t)l_ * 1024 * 4096, (bf16_t*)(ws + WS_WFF1) + (size_t)l_ * 4096 * 1024, nullptr, 4096, 1024, 0, r_}; ok_ = true; } \
        else if ((r_ -= I_F1) < I_F2) { t_ = TItem{karg(18) + (size_t)l_ * 4096 * 1024, (bf16_t*)(ws + WS_WFF2) + (size_t)l_ * 1024 * 4096, nullptr, 1024, 4096, 0, r_}; ok_ = true; } } } while (0)
    TItem tc{}, tn{}; bool okc, okn; float rc[32], rn[32];
    DECODE_T(gw, tc, okc);
    if (okc) titem_issue(tc, rc, lane);
    for (int it = gw; it < 2 * I_LAYER; it += NGW) {
        DECODE_T(it + NGW, tn, okn);
        if (okn) titem_issue(tn, rn, lane);
        if (okc) {
            titem_finish(tc, rc, scr, lane);
#pragma unroll
            for (int i = 0; i < 32; ++i) rc[i] = rn[i];
            tc = tn; okc = okn;
            continue;
        }
#pragma unroll
        for (int i = 0; i < 32; ++i) rc[i] = rn[i];
        tc = tn; okc = okn;
        const int l = it / I_LAYER; int r = it - l * I_LAYER - (I_IN + I_UQ + I_UKV + I_OUT + I_F1 + I_F2);
        bf16_t* win = (bf16_t*)(ws + WS_WIN) + (size_t)l * 1792 * 1024;
        bf16_t* wukv = (bf16_t*)(ws + WS_WUKV) + (size_t)l * 1024 * 256;
        bf16_t* wout = (bf16_t*)(ws + WS_WOUT) + (size_t)l * 1024 * 1024;
        if (r < I_POOL) {
            const int g = r >> 7, nb = (r >> 3) & 15, cc = r & 7, n = nb * 64 + lane;
            const float* wpool = karg(13) + (size_t)(l * 4 + g) * 4096 + (size_t)cc * 8 * 64; const float psd = karg(14)[l * 256 + g * 64 + lane];
#pragma unroll
            for (int j = 0; j < 8; ++j) scr[lane * 8 + j] = wpool[j * 64 + lane] * psd;
            asm volatile("s_waitcnt lgkmcnt(0)" ::: "memory");
            const float* wo = karg(15) + (size_t)l * 1024 * 1024 + (size_t)(768 + g * 64) * 1024 + n;
            float acc[8];
#pragma unroll
            for (int j = 0; j < 8; ++j) acc[j] = 0.f;
#pragma unroll 1
            for (int dh = 0; dh < 4; ++dh) {
                float wv[16];
#pragma unroll
                for (int d = 0; d < 16; ++d) wv[d] = wo[(size_t)(dh * 16 + d) * 1024];
#pragma unroll
                for (int d = 0; d < 16; ++d) {
                    const f32x4 s0 = *(const LAS f32x4*)(scr + (dh * 16 + d) * 8), s1 = *(const LAS f32x4*)(scr + (dh * 16 + d) * 8 + 4);
                    acc[0] += s0[0] * wv[d]; acc[1] += s0[1] * wv[d]; acc[2] += s0[2] * wv[d]; acc[3] += s0[3] * wv[d];
                    acc[4] += s1[0] * wv[d]; acc[5] += s1[1] * wv[d]; acc[6] += s1[2] * wv[d]; acc[7] += s1[3] * wv[d];
                }
            }
            u32x4 o; o.x = cvt_pk_bf16(acc[0], acc[1]); o.y = cvt_pk_bf16(acc[2], acc[3]); o.z = cvt_pk_bf16(acc[4], acc[5]); o.w = cvt_pk_bf16(acc[6], acc[7]);
            *(u32x4*)(wout + (size_t)n * 1024 + 768 + g * 64 + cc * 8) = o;
            asm volatile("s_waitcnt lgkmcnt(0)" ::: "memory");
            continue;
        } r -= I_POOL;
        {
            const u32x4 z = (u32x4){0u, 0u, 0u, 0u};
            u32x4* a = (u32x4*)(win + (size_t)1440 * 1024);
            for (int i = r * 64 + lane; i < 12288; i += 8 * 64) a[i] = z;
            for (int i = r * 64 + lane; i < 1024 * 16; i += 8 * 64) { const int row = i >> 4, ch = i & 15; *(u32x4*)(wukv + (size_t)row * 256 + 128 + ch * 8) = z; }
        }
    }
}

__device__ __forceinline__ void norm_phase(const float* src_lat, float* src_ctx, const float* part, const float* gain, const float* mod, int sh_off, int sc_off, bf16_t* dst, int row_lo, int nrows, int wave, int lane, int G) {
    int row = row_lo + fresh_bx() * 8 + wave; const int step = G * 8;
    f32x4 v[4], vn[4], vnn[4], c1[4], c1n[4], c1nn[4], c0[4], c0n[4], c0nn[4], g4[4];
#pragma unroll
    for (int j = 0; j < 4; ++j) g4[j] = *(const __attribute__((address_space(1))) f32x4*)(gain + (64 * j + lane) * 4);
#define NORM_LD(dst_, sc_, sh_, r_) do { if ((r_) < nrows) { const float* src_ = (r_) < ML ? src_lat + (size_t)(r_) * D : src_ctx + (size_t)((r_) - ML) * D; \
        const float* mr_ = mod + (size_t)((r_) < ML ? ((r_) >> 11) : 8) * 6144; \
        _Pragma("unroll") for (int j_ = 0; j_ < 4; ++j_) { dst_[j_] = *(const __attribute__((address_space(1))) f32x4*)(src_ + (64 * j_ + lane) * 4); \
            sc_[j_] = *(const __attribute__((address_space(1))) f32x4*)(mr_ + sc_off + (64 * j_ + lane) * 4); sh_[j_] = *(const __attribute__((address_space(1))) f32x4*)(mr_ + sh_off + (64 * j_ + lane) * 4); } } } while (0)
    NORM_LD(v, c1, c0, row); NORM_LD(vn, c1n, c0n, row + step);
    while (row < nrows) {
        NORM_LD(vnn, c1nn, c0nn, row + 2 * step);
        const bool lat = row < ML;
        float ss = 0.f;
#pragma unroll
        for (int j = 0; j < 4; ++j) {
            if (part && !lat) {
#pragma unroll
                for (int ks = 0; ks < 4; ++ks) v[j] += *(const f32x4*)(part + ((size_t)ks * MC + (row - ML)) * D + (64 * j + lane) * 4);
                *(f32x4*)(src_ctx + (size_t)(row - ML) * D + (64 * j + lane) * 4) = v[j];
            }
            ss += (v[j][0] * v[j][0] + v[j][1] * v[j][1]) + (v[j][2] * v[j][2] + v[j][3] * v[j][3]);
        }
        const float rstd = rsqrtf(wave_sum(ss) * (1.f / D) + EPS);
#pragma unroll
        for (int j = 0; j < 4; ++j) {
            const int c = (64 * j + lane) * 4;
            const f32x4 y = v[j] * rstd * g4[j] * (c1[j] + 1.f) + c0[j];
            u32x2 w; w.x = cvt_pk_bf16(y[0], y[1]); w.y = cvt_pk_bf16(y[2], y[3]);
            *(u32x2*)(dst + (size_t)row * D + c) = w;
        }
#pragma unroll
        for (int j = 0; j < 4; ++j) { v[j] = vn[j]; vn[j] = vnn[j]; c1[j] = c1n[j]; c1n[j] = c1nn[j]; c0[j] = c0n[j]; c0n[j] = c0nn[j]; }
        row += step;
    }
#undef NORM_LD
}

__device__ __forceinline__ bf16x8 pack8(const float* p) {
    u32x4 w; w.x = cvt_pk_bf16(p[0], p[1]); w.y = cvt_pk_bf16(p[2], p[3]); w.z = cvt_pk_bf16(p[4], p[5]); w.w = cvt_pk_bf16(p[6], p[7]);
    return __builtin_bit_cast(bf16x8, w);
}
__device__ __forceinline__ bf16x8 ldv8(const LAS unsigned char* p0, const LAS unsigned char* p1) {
    const u32x2 lo = *(const LAS u32x2*)p0, hi = *(const LAS u32x2*)p1;
    u32x4 w; w.x = lo.x; w.y = lo.y; w.z = hi.x; w.w = hi.y; return __builtin_bit_cast(bf16x8, w);
}

constexpr int KSTR_R = 144, KBUF_R = 64 * KSTR_R;
__device__ __forceinline__ void ret_unit(LAS unsigned char* lds, const bf16_t* RQ, const bf16_t* RK, const bf16_t* RVT, const bf16_t* RG, bf16_t* MIX,
                                         int b, int h, int qb, bool ctxq, float lf, float lb, int tid, int wave, int lane) {
    const int q = lane & 31, hi = lane >> 5;
    const int nct = ctxq ? 0 : 4, ntile = ctxq ? 4 : 36;
    const int ctxbase = ML + b * CTX, selfbase = ctxq ? ctxbase : b * SEQ;
    const int tq = qb * 256 + wave * 32 + q, qrow = selfbase + tq;
    bf16x8 qf[4];
#pragma unroll
    for (int ks = 0; ks < 4; ++ks) qf[ks] = *(const bf16x8*)(RQ + (size_t)qrow * 256 + h * 64 + ks * 16 + hi * 8);
    f32x16 o0, o1;
#pragma unroll
    for (int r = 0; r < 16; ++r) { o0[r] = 0.f; o1[r] = 0.f; }
    float cf[2][16], cb[2][16];
#pragma unroll
    for (int kb = 0; kb < 2; ++kb)
#pragma unroll
        for (int r = 0; r < 16; ++r) { const int key = 32 * kb + (r & 3) + 8 * (r >> 2) + 4 * hi; cf[kb][r] = fexp2(lf * (float)(63 - key)); cb[kb][r] = fexp2(lb * (float)key); }
    LAS unsigned char* Kt = lds; LAS unsigned char* Vt = lds + 2 * KBUF_R;
    const int lrow = tid >> 3, lpart = tid & 7;
    u32x4 kreg, vreg;
    { const int r0 = nct ? ctxbase : selfbase;
      kreg = gld16(RK + (size_t)(r0 + lrow) * 256 + h * 64 + lpart * 8); vreg = gld16(RVT + (size_t)(h * 64 + lrow) * MT + r0 + lpart * 8); }
#pragma unroll 1
    for (int kt = 0; kt < ntile; ++kt) {
        const int buf = kt & 1;
        *(LAS u32x4*)(Kt + buf * KBUF_R + lrow * KSTR_R + lpart * 16) = kreg; *(LAS u32x4*)(Vt + buf * KBUF_R + lrow * KSTR_R + lpart * 16) = vreg;
        __syncthreads();
        if (kt + 1 < ntile) { const int k1 = kt + 1; const int r0 = k1 < nct ? ctxbase + 64 * k1 : selfbase + 64 * (k1 - nct);
            kreg = gld16(RK + (size_t)(r0 + lrow) * 256 + h * 64 + lpart * 8); vreg = gld16(RVT + (size_t)(h * 64 + lrow) * MT + r0 + lpart * 8); }
        const LAS unsigned char* kb_ = Kt + buf * KBUF_R; const LAS unsigned char* vb_ = Vt + buf * KBUF_R;
        const bool isctx = kt < nct;
        const int kpos0 = isctx ? 64 * kt : 64 * (kt - nct);
        const int tw0 = qb * 256 + wave * 32;
        const bool fwd = isctx || (kpos0 + 63 <= tw0), bwd = isctx || (kpos0 > tw0 + 31), diag = !(fwd || bwd);
        const float rf = fwd ? fexp2(lf * (float)(tq - kpos0 - 63 + (isctx ? 256 : 0))) : 0.f;
        const float rb = bwd ? fexp2(lb * (float)(kpos0 - tq + (isctx ? 2048 : 0))) : 0.f;
#pragma unroll
        for (int kb = 0; kb < 2; ++kb) {
            f32x16 s;
#pragma unroll
            for (int r = 0; r < 16; ++r) s[r] = 0.f;
#pragma unroll
            for (int ks = 0; ks < 4; ++ks) { const bf16x8 af = *(const LAS bf16x8*)(kb_ + (32 * kb + q) * KSTR_R + (ks * 16 + hi * 8) * 2); s = __builtin_amdgcn_mfma_f32_32x32x16_bf16(af, qf[ks], s, 0, 0, 0); }
            float pv[16];
            if (diag) {
#pragma unroll
                for (int r = 0; r < 16; ++r) {
                    const int key = kpos0 + 32 * kb + (r & 3) + 8 * (r >> 2) + 4 * hi;
                    const int dd = tq - key;
                    pv[r] = s[r] * fexp2((dd >= 0 ? lf : -lb) * (float)dd);
                }
            } else {
#pragma unroll
                for (int r = 0; r < 16; ++r) pv[r] = s[r] * (rf * cf[kb][r] + rb * cb[kb][r]);
            }
            const bf16x8 pa0 = pack8(pv), pa1 = pack8(pv + 8);
#pragma unroll
            for (int sl = 0; sl < 2; ++sl) {
                const int base = 32 * kb + 16 * sl + 4 * hi;
                const bf16x8 v0 = ldv8(vb_ + q * KSTR_R + base * 2, vb_ + q * KSTR_R + (base + 8) * 2);
                const bf16x8 v1 = ldv8(vb_ + (32 + q) * KSTR_R + base * 2, vb_ + (32 + q) * KSTR_R + (base + 8) * 2);
                o0 = __builtin_amdgcn_mfma_f32_32x32x16_bf16(v0, sl ? pa1 : pa0, o0, 0, 0, 0);
                o1 = __builtin_amdgcn_mfma_f32_32x32x16_bf16(v1, sl ? pa1 : pa0, o1, 0, 0, 0);
            }
        }
    }
    __syncthreads();
    float sum = 0.f;
#pragma unroll
    for (int r = 0; r < 16; ++r) sum += o0[r] + o1[r];
    sum = xsum32(sum);
    const float mu = sum * (1.f / 64.f);
    float var = 0.f;
#pragma unroll
    for (int r = 0; r < 16; ++r) { const float a0 = o0[r] - mu, a1 = o1[r] - mu; var += a0 * a0 + a1 * a1; }
    var = xsum32(var);
    const float rs = rsqrtf(var * (1.f / 64.f) + EPS);
    LAS unsigned char* stg = lds + wave * 4608;
#pragma unroll
    for (int db = 0; db < 2; ++db)
#pragma unroll
        for (int rg = 0; rg < 4; ++rg) {
            const int d0 = 32 * db + 8 * rg + 4 * hi;
            const u32x2 g2 = *(const u32x2*)(RG + (size_t)qrow * 256 + h * 64 + d0);
            float y[4];
#pragma unroll
            for (int e = 0; e < 4; ++e) y[e] = ((db ? o1[4 * rg + e] : o0[4 * rg + e]) - mu) * rs;
            y[0] *= bf_lo(g2.x); y[1] *= bf_hi(g2.x); y[2] *= bf_lo(g2.y); y[3] *= bf_hi(g2.y);
            u32x2 w; w.x = cvt_pk_bf16(y[0], y[1]); w.y = cvt_pk_bf16(y[2], y[3]);
            *(LAS u32x2*)(stg + q * 136 + d0 * 2) = w;
        }
    asm volatile("s_waitcnt lgkmcnt(0)" ::: "memory");
    {
        const int rowb = selfbase + qb * 256 + wave * 32;
#pragma unroll
        for (int ps = 0; ps < 4; ++ps) {
            const int r = ps * 8 + (lane >> 3), ch = lane & 7;
            const u32x2 lo = *(const LAS u32x2*)(stg + r * 136 + ch * 16), hi2 = *(const LAS u32x2*)(stg + r * 136 + ch * 16 + 8);
            u32x4 w; w.x = lo.x; w.y = lo.y; w.z = hi2.x; w.w = hi2.y;
            *(u32x4*)(MIX + (size_t)(rowb + r) * D + h * 64 + ch * 8) = w;
        }
    }
    __syncthreads();
}

constexpr int KSTR_A = 208, KBUF_A = 64 * KSTR_A, VSTR_A = 144, VBUF_A = 64 * VSTR_A;
__device__ __forceinline__ void attn_tile(const LAS unsigned char* kb_, const LAS unsigned char* vb_, const bf16x8 (&qf)[6], f32x16& o0, f32x16& o1, float& mrun, float& lsum, int q, int hi) {
    f32x16 s0, s1;
#pragma unroll
    for (int r = 0; r < 16; ++r) { s0[r] = 0.f; s1[r] = 0.f; }
#pragma unroll
    for (int ks = 0; ks < 6; ++ks) {
        const bf16x8 a0 = *(const LAS bf16x8*)(kb_ + q * KSTR_A + (ks * 16 + hi * 8) * 2);
        const bf16x8 a1 = *(const LAS bf16x8*)(kb_ + (32 + q) * KSTR_A + (ks * 16 + hi * 8) * 2);
        s0 = __builtin_amdgcn_mfma_f32_32x32x16_bf16(a0, qf[ks], s0, 0, 0, 0);
        s1 = __builtin_amdgcn_mfma_f32_32x32x16_bf16(a1, qf[ks], s1, 0, 0, 0);
    }
    float mx = s0[0];
#pragma unroll
    for (int r = 1; r < 16; ++r) mx = fmaxf(mx, s0[r]);
#pragma unroll
    for (int r = 0; r < 16; ++r) mx = fmaxf(mx, s1[r]);
    mx = xmax32(mx);
    const float mnew = fmaxf(mrun, mx), alpha = fexp2(mrun - mnew);
    mrun = mnew;
    float p0[16], p1[16]; float rsum = 0.f;
#pragma unroll
    for (int r = 0; r < 16; ++r) { p0[r] = fexp2(s0[r] - mnew); p1[r] = fexp2(s1[r] - mnew); rsum += p0[r] + p1[r]; }
    lsum = lsum * alpha + rsum;
#pragma unroll
    for (int r = 0; r < 16; ++r) { o0[r] *= alpha; o1[r] *= alpha; }
#pragma unroll
    for (int kb = 0; kb < 2; ++kb) {
        const bf16x8 pa0 = pack8(kb ? p1 : p0), pa1 = pack8((kb ? p1 : p0) + 8);
#pragma unroll
        for (int sl = 0; sl < 2; ++sl) {
            const int base = 32 * kb + 16 * sl + 4 * hi;
            const bf16x8 v0 = ldv8(vb_ + q * VSTR_A + base * 2, vb_ + q * VSTR_A + (base + 8) * 2);
            const bf16x8 v1 = ldv8(vb_ + (32 + q) * VSTR_A + base * 2, vb_ + (32 + q) * VSTR_A + (base + 8) * 2);
            o0 = __builtin_amdgcn_mfma_f32_32x32x16_bf16(v0, sl ? pa1 : pa0, o0, 0, 0, 0);
            o1 = __builtin_amdgcn_mfma_f32_32x32x16_bf16(v1, sl ? pa1 : pa0, o1, 0, 0, 0);
        }
    }
}
__device__ __forceinline__ void attn_unit(LAS unsigned char* lds, const bf16_t* Q, const bf16_t* KN, const bf16_t* CKV, const bf16_t* VT, bf16_t* MIX,
                                          int b, int h, int qb, bool ctxq, int tid, int wave, int lane) {
    const int q = lane & 31, hi = lane >> 5;
    const int nct = ctxq ? 0 : 4, ntile = ctxq ? 4 : 36;
    const int ctxbase = ML + b * CTX, selfbase = ctxq ? ctxbase : b * SEQ;
    const int qrow = selfbase + qb * 256 + wave * 32 + q;
    bf16x8 qf[6];
#pragma unroll
    for (int ks = 0; ks < 6; ++ks) qf[ks] = *(const bf16x8*)(Q + (size_t)qrow * 768 + h * 96 + ks * 16 + hi * 8);
    f32x16 o0, o1;
#pragma unroll
    for (int r = 0; r < 16; ++r) { o0[r] = 0.f; o1[r] = 0.f; }
    float mrun = -1e30f, lsum = 0.f;
    LAS unsigned char* Kt = lds; LAS unsigned char* Vt = lds + 2 * KBUF_A;
    const int lrow = tid >> 3, lpart = tid & 7, prow = (tid & 255) >> 2, ppart = tid & 3;
    const bool pth = tid < 256;
    const bf16_t* kp = KN + (size_t)lrow * 512 + h * 64 + lpart * 8;
    const bf16_t* pp = CKV + (size_t)prow * 256 + 128 + ppart * 8;
    const bf16_t* vp = VT + (size_t)(h * 64 + lrow) * MT + lpart * 8;
    LAS unsigned char* kw = Kt + lrow * KSTR_A + lpart * 16; LAS unsigned char* pw = Kt + prow * KSTR_A + 128 + ppart * 16; LAS unsigned char* vw = Vt + lrow * VSTR_A + lpart * 16;
#define ATT_ROW0(k1) ((k1) < nct ? ctxbase + 64 * (k1) : selfbase + 64 * ((k1) - nct))
    u32x4 kA, pA, vA, kB, pB, vB;
    { const int r0 = ATT_ROW0(0); kA = gld16(kp + (size_t)r0 * 512); pA = gld16(pp + (size_t)r0 * 256); vA = gld16(vp + r0); }
    { const int r0 = ATT_ROW0(1); kB = gld16(kp + (size_t)r0 * 512); pB = gld16(pp + (size_t)r0 * 256); vB = gld16(vp + r0); }
#pragma unroll 1
    for (int kt = 0; kt < ntile; kt += 2) {
        *(LAS u32x4*)kw = kA; if (pth) *(LAS u32x4*)pw = pA; *(LAS u32x4*)vw = vA;
        __syncthreads();
        if (kt + 2 < ntile) { const int r0 = ATT_ROW0(kt + 2); kA = gld16(kp + (size_t)r0 * 512); pA = gld16(pp + (size_t)r0 * 256); vA = gld16(vp + r0); }
        attn_tile(Kt, Vt, qf, o0, o1, mrun, lsum, q, hi);
        *(LAS u32x4*)(kw + KBUF_A) = kB; if (pth) *(LAS u32x4*)(pw + KBUF_A) = pB; *(LAS u32x4*)(vw + VBUF_A) = vB;
        __syncthreads();
        if (kt + 3 < ntile) { const int r0 = ATT_ROW0(kt + 3); kB = gld16(kp + (size_t)r0 * 512); pB = gld16(pp + (size_t)r0 * 256); vB = gld16(vp + r0); }
        attn_tile(Kt + KBUF_A, Vt + VBUF_A, qf, o0, o1, mrun, lsum, q, hi);
    }
#undef ATT_ROW0
    __syncthreads();
    const float ltot = xsum32(lsum);
    const float inv = 1.f / ltot;
    LAS unsigned char* stg = lds + wave * 4608;
#pragma unroll
    for (int db = 0; db < 2; ++db)
#pragma unroll
        for (int rg = 0; rg < 4; ++rg) {
            const int d0 = 32 * db + 8 * rg + 4 * hi;
            float y[4];
#pragma unroll
            for (int e = 0; e < 4; ++e) y[e] = (db ? o1[4 * rg + e] : o0[4 * rg + e]) * inv;
            u32x2 w; w.x = cvt_pk_bf16(y[0], y[1]); w.y = cvt_pk_bf16(y[2], y[3]);
            *(LAS u32x2*)(stg + q * 136 + d0 * 2) = w;
        }
    asm volatile("s_waitcnt lgkmcnt(0)" ::: "memory");
    {
        const int rowb = selfbase + qb * 256 + wave * 32;
#pragma unroll
        for (int ps = 0; ps < 4; ++ps) {
            const int r = ps * 8 + (lane >> 3), ch = lane & 7;
            const u32x2 lo = *(const LAS u32x2*)(stg + r * 136 + ch * 16), hi2 = *(const LAS u32x2*)(stg + r * 136 + ch * 16 + 8);
            u32x4 w; w.x = lo.x; w.y = lo.y; w.z = hi2.x; w.w = hi2.y;
            *(u32x4*)(MIX + (size_t)(rowb + r) * D + 256 + h * 64 + ch * 8) = w;
        }
    }
    __syncthreads();
}

template <int W>
__device__ __forceinline__ void pool_rows(const bf16_t* U, bf16_t* MIX, int row, int c0) {
    int t, L;
    if (row < ML) { t = row & 2047; L = SEQ; } else { t = (row - ML) & 255; L = CTX; }
    const int base = row - t, lo = t - W / 2;
    u32x4 v[W];
#pragma unroll
    for (int k = 0; k < W; ++k) { int pos = lo + k; pos = pos < 0 ? 0 : (pos > L - 1 ? L - 1 : pos); v[k] = gld16(U + (size_t)(base + pos) * 256 + c0); }
    const u32x4 me = gld16(U + (size_t)row * 256 + c0);
    float s[8];
#pragma unroll
    for (int e = 0; e < 8; ++e) s[e] = 0.f;
#pragma unroll
    for (int k = 0; k < W; ++k) {
        const int pos = lo + k; const float m = (pos >= 0 && pos < L) ? 1.f : 0.f;
        s[0] += m * bf_lo(v[k].x); s[1] += m * bf_hi(v[k].x); s[2] += m * bf_lo(v[k].y); s[3] += m * bf_hi(v[k].y);
        s[4] += m * bf_lo(v[k].z); s[5] += m * bf_hi(v[k].z); s[6] += m * bf_lo(v[k].w); s[7] += m * bf_hi(v[k].w);
    }
    const int hi_ = (lo + W > L) ? L : lo + W, lo_ = lo < 0 ? 0 : lo;
    const float inv = 1.f / (float)(hi_ - lo_);
    float y[8];
    y[0] = s[0] * inv - bf_lo(me.x); y[1] = s[1] * inv - bf_hi(me.x); y[2] = s[2] * inv - bf_lo(me.y); y[3] = s[3] * inv - bf_hi(me.y);
    y[4] = s[4] * inv - bf_lo(me.z); y[5] = s[5] * inv - bf_hi(me.z); y[6] = s[6] * inv - bf_lo(me.w); y[7] = s[7] * inv - bf_hi(me.w);
    u32x4 o; o.x = cvt_pk_bf16(y[0], y[1]); o.y = cvt_pk_bf16(y[2], y[3]); o.z = cvt_pk_bf16(y[4], y[5]); o.w = cvt_pk_bf16(y[6], y[7]);
    *(u32x4*)(MIX + (size_t)row * D + 768 + c0) = o;
}
__device__ __forceinline__ void pool_phase(const bf16_t* U, bf16_t* MIX, int wave, int lane, int G) {
    constexpr int RB = MT / 8;
    for (int it = fresh_bx() * 8 + wave; it < 4 * RB; it += G * 8) {
        const int g = it / RB, rb = it - g * RB, row = rb * 8 + (lane >> 3), c0 = g * 64 + (lane & 7) * 8;
        if (g == 0) pool_rows<2>(U, MIX, row, c0);
        else if (g == 1) pool_rows<4>(U, MIX, row, c0);
        else if (g == 2) pool_rows<8>(U, MIX, row, c0);
        else pool_rows<16>(U, MIX, row, c0);
    }
}


#define XB_TMO      128
#define XB_XCNT(j)  (256  + 64 * (j))
#define XB_XSUB(j)  (1280 + 64 * (j))
#define XB_XGEN(j)  (2304 + 64 * (j))
#define XB_TOP      3328
#define XB_TOPGEN   3392
#define XCD_BAR_WORDS 3456
#define XB_SPIN_CAP (1u << 18)
__device__ __forceinline__ unsigned xb_ld(unsigned* p)              { return __hip_atomic_load(p, __ATOMIC_RELAXED, __HIP_MEMORY_SCOPE_AGENT); }
__device__ __forceinline__ unsigned xb_add(unsigned* p, unsigned v) { return __hip_atomic_fetch_add(p, v, __ATOMIC_RELAXED, __HIP_MEMORY_SCOPE_AGENT); }
__device__ __forceinline__ unsigned xb_xcc_id() { return (unsigned)__builtin_amdgcn_s_getreg((3 << 11) | 20) & 0xFu; }
#define XB_SPIN(cond, bar) do { unsigned _sp = 0; while (cond) { __builtin_amdgcn_s_sleep(1); \
    if ((++_sp & 255u) == 0u) { if (xb_ld(&(bar)[XB_TMO])) break; if (_sp > XB_SPIN_CAP) { atomicAdd(&(bar)[XB_TMO], 1u); break; } } } } while (0)
__device__ __forceinline__ void xcd_barrier_complete(unsigned* bar, unsigned x, unsigned G, unsigned& nloc, unsigned& nx) {
    unsigned sum, cnt, mine, sp = 0u;
    for (;;) {
        sum = 0u; cnt = 0u; mine = 0u;
#pragma unroll
        for (unsigned j = 0; j < 16; ++j) { const unsigned c = xb_ld(&bar[XB_XCNT(j)]); sum += c; cnt += (c > 0u) ? 1u : 0u; mine = (j == x) ? c : mine; }
        if (sum == G) break;
        __builtin_amdgcn_s_sleep(1);
        if ((++sp & 255u) == 0u) { if (xb_ld(&bar[XB_TMO])) break; if (sp > XB_SPIN_CAP) { atomicAdd(&bar[XB_TMO], 1u); break; } }
    }
    nloc = mine > 0u ? mine : 1u; nx = cnt > 0u ? cnt : 1u;
}
__device__ __forceinline__ void xcd_barrier(unsigned* bar, volatile LAS unsigned* st, unsigned G, bool first) {
    asm volatile("s_waitcnt vmcnt(0)" ::: "memory");
    __syncthreads();
    if (first) {
        __builtin_amdgcn_s_waitcnt(0);
        const unsigned x = xb_xcc_id();
        unsigned nloc = st[0], nx = st[1];
        if (nloc == 0u) { xcd_barrier_complete(bar, x, G, nloc, nx); st[0] = nloc; st[1] = nx; }
        const unsigned old = xb_add(&bar[XB_XSUB(x)], 1u);
        const unsigned gen = old / nloc;
        if (old + 1u == (gen + 1u) * nloc) {
            __builtin_amdgcn_fence(__ATOMIC_RELEASE, "agent");
            asm volatile("s_waitcnt vmcnt(0)" ::: "memory");
            const unsigned og = xb_add(&bar[XB_TOP], 1u);
            const unsigned tg = og / nx;
            if (og + 1u == (tg + 1u) * nx) xb_add(&bar[XB_TOPGEN], 1u);
            else XB_SPIN(xb_ld(&bar[XB_TOPGEN]) == tg, bar);
            __builtin_amdgcn_fence(__ATOMIC_ACQUIRE, "agent");
            xb_add(&bar[XB_XGEN(x)], 1u);
            asm volatile("s_waitcnt vmcnt(0)" ::: "memory");
        } else {
            XB_SPIN(xb_ld(&bar[XB_XGEN(x)]) == gen, bar);
            __builtin_amdgcn_fence(__ATOMIC_ACQUIRE, "agent");
            asm volatile("s_waitcnt vmcnt(0)" ::: "memory");
        }
    }
    __syncthreads();
}

#ifndef NSYNC
#define NSYNC 1
#endif
#define GSYNC() do { for (int s_ = 0; s_ < NSYNC; ++s_) xcd_barrier(WSP(unsigned, WS_BAR), bst, (unsigned)G, wave0 == 0 && fresh_lane() == 0); } while (0)
#define WSP(T, off) ((T*)(karg_ws() + (off)))
__global__ void __launch_bounds__(512, 2) mega_fwd(Params p) {
    extern __shared__ __attribute__((aligned(16))) unsigned char lds_raw[];
    LAS unsigned char* lds = (LAS unsigned char*)lds_raw;
    cg::grid_group grid = cg::this_grid();
    const int wave0 = __builtin_amdgcn_readfirstlane(threadIdx.x >> 6);
    int wave = wave0, lane = fresh_lane(), tid = wave * 64 + lane;
#define FRESH() do { lane = fresh_lane(); wave = wave0; tid = wave * 64 + lane; } while (0)
    constexpr int G = 256; const int bx0 = blockIdx.x; int bx = bx0;

    volatile LAS unsigned* bst = (volatile LAS unsigned*)(lds + 131072 + 64);
    if (tid == 0) { bst[0] = 0u; bst[1] = 0u; }
    if (bx == 0) { unsigned* bw = WSP(unsigned, WS_BAR); for (int i = tid; i < XCD_BAR_WORDS; i += 512) bw[i] = 0u; }
    for (int rep_ = 0; rep_ < NREP(0); ++rep_) { __syncthreads(); prologue(lds, tid, wave, lane, G); }
    grid.sync();
    if (wave0 == 0 && fresh_lane() == 0) (void)xb_add(&WSP(unsigned, WS_BAR)[XB_XCNT(xb_xcc_id())], 1u);

#pragma unroll 1
    for (int l = 0; l < 2; ++l) {
        bx = bx0; asm volatile("" : "+s"(bx));
        const bool last = (l == 1);
        const int Mx = last ? ML : MT;

        for (int rep_ = 0; rep_ < NREP(1); ++rep_) {
            FRESH();
            const float* xs_lat = l == 0 ? karg(0) : karg_out();
            if (l == 0) {
                norm_phase(xs_lat, (float*)karg(2), nullptr, karg(6) + l * D, WSP(float, WS_MOD) + (size_t)l * 9 * 6144, 0, 1024, WSP(bf16_t, WS_HX), 0, MT, wave, lane, G);
            } else {
                norm_phase(xs_lat, WSP(float, WS_H), WSP(float, WS_HX), karg(6) + l * D, WSP(float, WS_MOD) + (size_t)l * 9 * 6144, 0, 1024, WSP(bf16_t, WS_HX), ML, MT, wave, lane, G);
                GSYNC();
                FRESH();
                norm_phase(xs_lat, WSP(float, WS_H), nullptr, karg(6) + l * D, WSP(float, WS_MOD) + (size_t)l * 9 * 6144, 0, 1024, WSP(bf16_t, WS_HX), 0, ML, wave, lane, G);
            }
        }
        GSYNC();
        for (int rep_ = 0; rep_ < NREP(2); ++rep_) {
            if (RUN(13)) {
                const bf16_t* win = WSP(bf16_t, WS_WIN) + (size_t)l * 1792 * 1024;
                EpiArgs ea{}; ea.o0 = WSP(bf16_t, WS_RQ); ea.o1 = WSP(bf16_t, WS_RK); ea.o2 = WSP(bf16_t, WS_RG); ea.o3 = WSP(bf16_t, WS_CQ); ea.o4 = WSP(bf16_t, WS_U); ea.o5 = WSP(bf16_t, WS_CKV);
                ea.ssq_q = WSP(float, WS_SSQQ); ea.ssq_k = WSP(float, WS_SSQK);
                pg8::Gemm g{WSP(bf16_t, WS_HX), win, 1024, 1024, 1024}; pg8::StaticOrder S; S.init(MT, NIN, G, bx);
                Epi<EP_IN> E{ea};
                pg8::gemm_phase<Epi<EP_IN>, true>(lds, g, S, E, wave0);
            }
            if (RUN(14)) {
                const bf16_t* win = WSP(bf16_t, WS_WIN) + (size_t)l * 1792 * 1024;
                EpiArgs eb{}; eb.o0 = WSP(bf16_t, WS_RVT);
                pg8::Gemm g2{win + (size_t)1536 * 1024, WSP(bf16_t, WS_HX), 1024, 1024, 1024}; pg8::StaticOrder S2; S2.init(256, MT, G, (bx + G - 176) % G);
                Epi<EP_RVT> E2{eb};
                pg8::gemm_phase<Epi<EP_RVT>, true>(lds, g2, S2, E2, wave0);
            }
        }
        GSYNC();
        for (int rep_ = 0; rep_ < NREP(3); ++rep_) {
            if (RUN(8)) {
                EpiArgs ea{}; ea.o0 = WSP(bf16_t, WS_Q); ea.ssq_q = WSP(float, WS_SSQQ);
                pg8::Gemm g{WSP(bf16_t, WS_CQ), WSP(bf16_t, WS_WUQ) + (size_t)l * 768 * 256, 256, 256, 256}; pg8::StaticOrder S; S.init(Mx, 768, G, bx);
                Epi<EP_UPQ> E{ea};
                pg8::gemm_phase<Epi<EP_UPQ>, true>(lds, g, S, E, wave0);
            }
            if (RUN(9)) {
                EpiArgs eb{}; eb.o0 = WSP(bf16_t, WS_KN); eb.ssq_k = WSP(float, WS_SSQK);
                pg8::Gemm g2{WSP(bf16_t, WS_CKV), WSP(bf16_t, WS_WUKV) + (size_t)l * 1024 * 256, 256, 256, 256}; pg8::StaticOrder S2; S2.init(MT, 512, G, (bx + 40) % G);
                Epi<EP_UPK> E2{eb};
                pg8::gemm_phase<Epi<EP_UPK>, true>(lds, g2, S2, E2, wave0);
            }
            if (RUN(10)) {
                EpiArgs ec{}; ec.o0 = WSP(bf16_t, WS_VT); ec.ssq_k = WSP(float, WS_SSQK);
                pg8::Gemm g3{WSP(bf16_t, WS_WUKV) + (size_t)l * 1024 * 256 + (size_t)512 * 256, WSP(bf16_t, WS_CKV), 256, 256, 256}; pg8::StaticOrder S3; S3.init(512, MT, G, (bx + G - 104) % G);
                Epi<EP_VT> E3{ec};
                pg8::gemm_phase<Epi<EP_VT>, true>(lds, g3, S3, E3, wave0);
            }
            if (RUN(11)) {
                FRESH();
                const float* dl = karg(12) + l * 8;
                const int xcd = bx & 7, slot = bx >> 3;
                if (bx < 256) {
                    const int bh = xcd * 4 + (slot >> 3), qb = slot & 7, b = bh >> 2, h = bh & 3;
                    const float lf = -log1pf(expf(-dl[h])) * 1.4426950408889634f, lb = -log1pf(expf(-dl[4 + h])) * 1.4426950408889634f;
                    ret_unit(lds, WSP(bf16_t, WS_RQ), WSP(bf16_t, WS_RK), WSP(bf16_t, WS_RVT), WSP(bf16_t, WS_RG), WSP(bf16_t, WS_MIX), b, h, qb, false, lf, lb, tid, wave, lane);
                }
                if (!last && bx >= 128 && bx < 160) {
                    const int bh = bx - 128, b = bh >> 2, h = bh & 3;
                    const float lf = -log1pf(expf(-dl[h])) * 1.4426950408889634f, lb = -log1pf(expf(-dl[4 + h])) * 1.4426950408889634f;
                    ret_unit(lds, WSP(bf16_t, WS_RQ), WSP(bf16_t, WS_RK), WSP(bf16_t, WS_RVT), WSP(bf16_t, WS_RG), WSP(bf16_t, WS_MIX), b, h, 0, true, lf, lb, tid, wave, lane);
                }
            }
            if (RUN(12)) { FRESH(); pool_phase(WSP(bf16_t, WS_U), WSP(bf16_t, WS_MIX), wave, lane, G); }
        }
        GSYNC();
        for (int rep_ = 0; rep_ < NREP(4); ++rep_) {
            FRESH();
            const int xcd = bx & 7, slot = bx >> 3;
            if (bx < 256) {
#pragma unroll 1
                for (int rd = 0; rd < 2; ++rd) {
                    const int bh = rd * 32 + xcd * 4 + (slot >> 3), qb = slot & 7, b = bh >> 3, h = bh & 7;
                    attn_unit(lds, WSP(bf16_t, WS_Q), WSP(bf16_t, WS_KN), WSP(bf16_t, WS_CKV), WSP(bf16_t, WS_VT), WSP(bf16_t, WS_MIX), b, h, qb, false, tid, wave, lane);
                }
            }
            if (!last && bx < 64) attn_unit(lds, WSP(bf16_t, WS_Q), WSP(bf16_t, WS_KN), WSP(bf16_t, WS_CKV), WSP(bf16_t, WS_VT), WSP(bf16_t, WS_MIX), bx >> 3, bx & 7, 0, true, tid, wave, lane);
        }
        GSYNC();
        if (RUN(5)) {
            {
                EpiArgs ea{}; ea.xin_lat = l == 0 ? karg(0) : karg_out(); ea.xin_ctx = WSP(float, WS_H); ea.xout_lat = karg_out(); ea.xout_ctx = WSP(float, WS_H);
                ea.mod = WSP(float, WS_MOD) + (size_t)l * 9 * 6144;
                pg8::Gemm g{WSP(bf16_t, WS_MIX), WSP(bf16_t, WS_WOUT) + (size_t)l * 1024 * 1024, 1024, 1024, 1024}; pg8::StaticOrder S; S.init(ML, 1024, G, bx);
                Epi<EP_OUT> E{ea};
                pg8::gemm_phase<Epi<EP_OUT>, false>(lds, g, S, E, wave0);
            }
            if (!last) {
                const int ks = bx >> 5;
                EpiArgs ea{}; ea.xin_lat = karg_out(); ea.xin_ctx = WSP(float, WS_H); ea.xout_lat = karg_out(); ea.xout_ctx = WSP(float, WS_RQ) + (size_t)ks * MC * D;
                ea.mod = WSP(float, WS_MOD) + (size_t)l * 9 * 6144; ea.row_off = ML;
                pg8::Gemm g{WSP(bf16_t, WS_MIX) + (size_t)ML * 1024 + ks * 256, WSP(bf16_t, WS_WOUT) + (size_t)l * 1024 * 1024 + ks * 256, 1024, 1024, 256};
                pg8::StaticOrder S; S.init(MC, 1024, G, bx < 128 ? (bx & 31) : 255);
                Epi<EP_OUTA> E{ea};
                pg8::gemm_phase<Epi<EP_OUTA>, true>(lds, g, S, E, wave0);
            }
        }
        GSYNC();
        if (RUN(1)) {
            FRESH();
            norm_phase(karg_out(), WSP(float, WS_H), last ? nullptr : WSP(float, WS_RQ), karg(16) + l * D, WSP(float, WS_MOD) + (size_t)l * 9 * 6144, 3072, 4096, WSP(bf16_t, WS_HX), 0, Mx, wave, lane, G);
        }
        GSYNC();
        for (int rep_ = 0; rep_ < NREP(6); ++rep_) {
            EpiArgs ea{}; ea.o0 = WSP(bf16_t, WS_F);
            pg8::Gemm g{WSP(bf16_t, WS_HX), WSP(bf16_t, WS_WFF1) + (size_t)l * 4096 * 1024, 1024, 1024, 1024}; pg8::StaticOrder S; S.init(Mx, FF, G, bx);
            Epi<EP_FF1> E{ea};
            pg8::gemm_phase<Epi<EP_FF1>, true>(lds, g, S, E, wave0);
        }
        GSYNC();
        if (RUN(7)) {
            {
                EpiArgs ea{}; ea.xin_lat = karg_out(); ea.xin_ctx = WSP(float, WS_H); ea.xout_lat = karg_out(); ea.xout_ctx = WSP(float, WS_H);
                ea.mod = WSP(float, WS_MOD) + (size_t)l * 9 * 6144;
                pg8::Gemm g{WSP(bf16_t, WS_F), WSP(bf16_t, WS_WFF2) + (size_t)l * 1024 * 4096, 4096, 4096, 4096}; pg8::StaticOrder S; S.init(ML, 1024, G, bx);
                Epi<EP_FF2> E{ea};
                pg8::gemm_phase<Epi<EP_FF2>, false>(lds, g, S, E, wave0);
            }
            if (!last) {
                const int ks = bx >> 5;
                EpiArgs ea{}; ea.xin_lat = karg_out(); ea.xin_ctx = WSP(float, WS_H); ea.xout_lat = karg_out(); ea.xout_ctx = WSP(float, WS_HX) + (size_t)ks * MC * D;
                ea.mod = WSP(float, WS_MOD) + (size_t)l * 9 * 6144; ea.row_off = ML;
                pg8::Gemm g{WSP(bf16_t, WS_F) + (size_t)ML * 4096 + ks * 1024, WSP(bf16_t, WS_WFF2) + (size_t)l * 1024 * 4096 + ks * 1024, 4096, 4096, 1024};
                pg8::StaticOrder S; S.init(MC, 1024, G, bx < 128 ? (bx & 31) : 255);
                Epi<EP_FF2A> E{ea};
                pg8::gemm_phase<Epi<EP_FF2A>, true>(lds, g, S, E, wave0);
            }
        }
        GSYNC();
    }
    {
        FRESH();
        const float* gain = karg(19); float* outp = karg_out();
        int row = bx * 8 + wave; const int step = G * 8;
        f32x4 v[4], vn[4], vnn[4], g4[4];
#pragma unroll
        for (int j = 0; j < 4; ++j) g4[j] = *(const __attribute__((address_space(1))) f32x4*)(gain + (64 * j + lane) * 4);
#define FIN_LD(dst_, r_) do { if ((r_) < ML) { _Pragma("unroll") for (int j_ = 0; j_ < 4; ++j_) dst_[j_] = *(const __attribute__((address_space(1))) f32x4*)(outp + (size_t)(r_) * D + (64 * j_ + lane) * 4); } } while (0)
        FIN_LD(v, row); FIN_LD(vn, row + step);
        while (row < ML) {
            FIN_LD(vnn, row + 2 * step);
            float* xr = outp + (size_t)row * D;
            float ss = 0.f;
#pragma unroll
            for (int j = 0; j < 4; ++j) ss += (v[j][0] * v[j][0] + v[j][1] * v[j][1]) + (v[j][2] * v[j][2] + v[j][3] * v[j][3]);
            const float rstd = rsqrtf(wave_sum(ss) * (1.f / D) + EPS);
#pragma unroll
            for (int j = 0; j < 4; ++j) { const int c = (64 * j + lane) * 4; *(f32x4*)(xr + c) = v[j] * rstd * g4[j]; }
#pragma unroll
            for (int j = 0; j < 4; ++j) { v[j] = vn[j]; vn[j] = vnn[j]; }
            row += step;
        }
#undef FIN_LD
    }
}

extern "C" void kernel_launch(void* const* d_in, const int* in_sizes, int n_in, void* d_out, int out_size, void* d_ws, size_t ws_size, hipStream_t stream) {
    static int grid_blocks = 0;
    if (grid_blocks == 0) {
        if (n_in != 20 || ws_size < WS_END) { fprintf(stderr, "kernel_launch: unexpected inputs (n_in %d, ws %zu)\n", n_in, ws_size); grid_blocks = -1; return; }
        int dev = 0, cus = 0, per_cu = 0;
        hipGetDevice(&dev);
        hipDeviceGetAttribute(&cus, hipDeviceAttributeMultiprocessorCount, dev);
        if (hipFuncSetAttribute((const void*)mega_fwd, hipFuncAttributeMaxDynamicSharedMemorySize, LDS_BYTES) != hipSuccess) { fprintf(stderr, "kernel_launch: hipFuncSetAttribute failed\n"); grid_blocks = -1; return; }
        if (hipOccupancyMaxActiveBlocksPerMultiprocessor(&per_cu, (const void*)mega_fwd, 512, LDS_BYTES) != hipSuccess || per_cu < 1) { fprintf(stderr, "kernel_launch: occupancy query failed (%d)\n", per_cu); (void)hipGetLastError(); per_cu = 1; }
        grid_blocks = cus * (per_cu > 1 ? 1 : per_cu);
        if (grid_blocks < 256) { fprintf(stderr, "kernel_launch: needs 256 co-resident workgroups, device offers %d\n", grid_blocks); grid_blocks = -1; return; }
        grid_blocks = 256;
    }
    if (grid_blocks < 0) return;
    Params p{};
    for (int i = 0; i < 20; ++i) p.in[i] = (const float*)d_in[i];
    p.out = (float*)d_out; p.ws = (unsigned char*)d_ws;
    void* args[] = {&p};
    hipError_t e = hipLaunchCooperativeKernel((const void*)mega_fwd, dim3(grid_blocks), dim3(512), args, LDS_BYTES, stream);
    if (e != hipSuccess) fprintf(stderr, "cooperative launch failed: %s (grid %d)\n", hipGetErrorString(e), grid_blocks);
}
```

```cpp
#include <hip/hip_runtime.h>
#include <hip/hip_cooperative_groups.h>
#include <cstdio>
#include <cstdint>
namespace cg = cooperative_groups;

#define LAS __attribute__((address_space(3)))
typedef unsigned short bf16_t;
typedef short bf16x8 __attribute__((ext_vector_type(8)));
typedef float f32x4 __attribute__((ext_vector_type(4)));
typedef float f32x16 __attribute__((ext_vector_type(16)));
typedef unsigned u32x4 __attribute__((ext_vector_type(4)));
typedef unsigned u32x2 __attribute__((ext_vector_type(2)));

constexpr int D = 1024, NB = 8, SEQ = 2048, CTX = 256;
constexpr int ML = NB * SEQ;
constexpr int MC = NB * CTX;
constexpr int MT = ML + MC;
constexpr int FF = 4096, INW = 1696, NIN = 1536;
constexpr float EPS = 1e-6f;
constexpr float QSCALE = 0.10206207261596575f * 1.4426950408889634f;

constexpr size_t MiB = 1u << 20;
constexpr size_t WS_WIN = 0;
constexpr size_t WS_WUQ = 7 * MiB;
constexpr size_t WS_WUKV = 8 * MiB;
constexpr size_t WS_WOUT = 9 * MiB;
constexpr size_t WS_WFF1 = 13 * MiB;
constexpr size_t WS_WFF2 = 29 * MiB;
constexpr size_t WS_MOD = 45 * MiB;
constexpr size_t WS_H = 46 * MiB;
constexpr size_t WS_HX = 54 * MiB;
constexpr size_t WS_SSQQ = 90 * MiB;
constexpr size_t WS_SSQK = 90 * MiB + 512 * 1024;
constexpr size_t WS_F = 91 * MiB;
constexpr size_t WS_RQ = 91 * MiB, WS_RK = 100 * MiB, WS_RG = 109 * MiB, WS_CQ = 118 * MiB, WS_U = 127 * MiB, WS_RVT = 136 * MiB;
constexpr size_t WS_CKV = 145 * MiB;
constexpr size_t WS_Q = 154 * MiB;
constexpr size_t WS_KN = 181 * MiB;
constexpr size_t WS_VT = 199 * MiB;
constexpr size_t WS_MIX = 217 * MiB;
constexpr size_t WS_BAR = 253 * MiB;
constexpr size_t WS_END = 254 * MiB;

#ifndef SKIPMASK
#define SKIPMASK 0
#endif
#define RUN(bit) (!((SKIPMASK >> (bit)) & 1))
#ifndef DUPMASK
#define DUPMASK 0
#endif
#define NREP(bit) (1 + ((DUPMASK >> (bit)) & 1))
constexpr int LDS_BYTES = 135168;

__device__ __forceinline__ unsigned cvt_pk_bf16(float lo, float hi) { unsigned r; asm("v_cvt_pk_bf16_f32 %0, %1, %2" : "=v"(r) : "v"(lo), "v"(hi)); return r; }
__device__ __forceinline__ float bf_lo(unsigned u) { return __uint_as_float(u << 16); }
__device__ __forceinline__ float bf_hi(unsigned u) { return __uint_as_float(u & 0xffff0000u); }
__device__ __forceinline__ int fresh_bx() { int b = blockIdx.x; asm volatile("" : "+s"(b)); return b; }
__device__ __forceinline__ int fresh_lane() { int l; asm volatile("v_mbcnt_lo_u32_b32 %0, -1, 0\n\tv_mbcnt_hi_u32_b32 %0, -1, %0" : "=v"(l)); return l; }
__device__ __forceinline__ float xsum32(float v) { auto r = __builtin_amdgcn_permlane32_swap(__float_as_uint(v), __float_as_uint(v), false, false); return __uint_as_float(r[0]) + __uint_as_float(r[1]); }
__device__ __forceinline__ float xmax32(float v) { auto r = __builtin_amdgcn_permlane32_swap(__float_as_uint(v), __float_as_uint(v), false, false); return fmaxf(__uint_as_float(r[0]), __uint_as_float(r[1])); }
__device__ __forceinline__ float xsum16(float v) { auto r = __builtin_amdgcn_permlane16_swap(__float_as_uint(v), __float_as_uint(v), false, false); return __uint_as_float(r[0]) + __uint_as_float(r[1]); }
__device__ __forceinline__ float dppf(float v, int ctrl_sel) {
    const int x = __float_as_int(v); int r;
    if (ctrl_sel == 0) r = __builtin_amdgcn_update_dpp(0, x, 0xB1, 0xF, 0xF, false);
    else if (ctrl_sel == 1) r = __builtin_amdgcn_update_dpp(0, x, 0x4E, 0xF, 0xF, false);
    else if (ctrl_sel == 2) r = __builtin_amdgcn_update_dpp(0, x, 0x141, 0xF, 0xF, false);
    else r = __builtin_amdgcn_update_dpp(0, x, 0x140, 0xF, 0xF, false);
    return __int_as_float(r);
}
__device__ __forceinline__ float wave_sum(float v) {
    v += dppf(v, 0); v += dppf(v, 1); v += dppf(v, 2); v += dppf(v, 3);
    v = xsum16(v); v = xsum32(v);
    return v;
}
__device__ __forceinline__ u32x4 gld16(const void* p) { return *(const __attribute__((address_space(1))) u32x4*)p; }
__device__ __forceinline__ float fexp2(float x) { return __builtin_amdgcn_exp2f(x); }

namespace pg8 {
constexpr int BM = 256, BK = 64, HALF = 128, HTB = HALF * BK * 2, STAGE_BYTES = 8 * HTB, NXCD = 8, WGM = 8;
__host__ __device__ __forceinline__ int lds_byte(int r, int c) { const int st = (r >> 4) * 2 + (c >> 5), rr = r & 15, cc = c & 31, ob = rr * 64 + cc * 2; return st * 1024 + (ob ^ (((ob >> 9) & 1) << 5)); }
__host__ __device__ __forceinline__ void stage_rc(int b, int& R, int& C) { const int st = b / 1024, sb = b % 1024, swz = sb ^ (((sb >> 9) & 1) << 5); R = (st >> 1) * 16 + swz / 64; C = (st & 1) * 32 + (swz % 64) / 2; }
__host__ __device__ __forceinline__ int perm32(int rho) { const int n = rho >> 4, i = rho & 15; return 8 * (i >> 2) + 4 * n + (i & 3); }

struct Unit { int pm, pn; };
struct Gemm { const bf16_t* A; const bf16_t* Bt; int lda, ldb, K; };

struct StaticOrder {
    int nM, nN, nwg, G, c;
    __device__ void init(int M, int N, int G_, int c_) { nM = M / BM; nN = N / BM; nwg = nM * nN; G = G_; c = c_; }
    __device__ bool next(int i, Unit& u) const {
        const long L = (long)i * G + c; if (L >= nwg) return false;
        int wgid = (int)L; { const int q = nwg / NXCD, r = nwg % NXCD, xcd = wgid % NXCD, off = wgid / NXCD; wgid = (xcd < r ? xcd * (q + 1) : r * (q + 1) + (xcd - r) * q) + off; }
        const int nig = WGM * nN, gid = wgid / nig, fm = gid * WGM, gsz = (nM - fm) < WGM ? (nM - fm) : WGM;
        u.pm = fm + ((wgid % nig) % gsz); u.pn = (wgid % nig) / gsz; return true;
    }
};

template <class Epi, bool ALIGN_EPI>
__device__ __forceinline__ void gemm_phase(LAS unsigned char* lds, const Gemm g, const StaticOrder& S, const Epi& E, int wid) {
    const int lane = fresh_lane(), tid = wid * 64 + lane, wr = wid >> 2, wc = wid & 3, fr = lane & 15, fq = lane >> 4;
    int K_ = g.K; if constexpr (Epi::OPAQUE_K) asm volatile("" : "+s"(K_));
    const int K = K_, nt = K / BK;
    unsigned voffA[2], voffB[2];
#pragma unroll
    for (int i = 0; i < 2; ++i) { int R, C; stage_rc(tid * 16 + i * 8192, R, C); const int Rb = Epi::PERM ? ((R & ~31) + perm32(R & 31)) : R;
        voffA[i] = (unsigned)(R * g.lda + C) * 2u; voffB[i] = (unsigned)(Rb * g.ldb + C) * 2u; }
    const size_t kstep = (size_t)(BK * 2);
    const size_t hstepA = (size_t)HALF * g.lda * 2, hstepB = (size_t)HALF * g.ldb * 2;
    const size_t tstepA = 2 * hstepA, tstepB = 2 * hstepB;
    const unsigned ldsw = (unsigned)wid * 1024u;
    const int aoff = lds_byte(wr * 64 + fr, fq * 8), boff = lds_byte(wc * 32 + fr, fq * 8);
#define PG8_SA(b, h) (((b) * 2 + (h)) * HTB)
#define PG8_SB(b, h) ((4 + (b) * 2 + (h)) * HTB)
#define PG8_STAGE(bufoff, gbase, voff) do { _Pragma("unroll") for (int _i = 0; _i < 2; ++_i) \
        __builtin_amdgcn_global_load_lds((const unsigned*)((const char*)(gbase) + (voff)[_i]), (LAS unsigned*)(lds + (bufoff) + ldsw + _i * 8192), 16, 0, 0); } while (0)
#define PG8_LDA(dst, b, h) do { _Pragma("unroll") for (int m = 0; m < 4; ++m) _Pragma("unroll") for (int k = 0; k < 2; ++k) dst[m][k] = *(const LAS bf16x8*)(lds + PG8_SA(b, h) + aoff + m * 2048 + k * 1024); } while (0)
#define PG8_LDB(dst, b, h) do { _Pragma("unroll") for (int n = 0; n < 2; ++n) _Pragma("unroll") for (int k = 0; k < 2; ++k) dst[n][k] = *(const LAS bf16x8*)(lds + PG8_SB(b, h) + boff + n * 2048 + k * 1024); } while (0)
#define PG8_MMA(ai, bj, At, Bt) do { __builtin_amdgcn_s_setprio(1); _Pragma("unroll") for (int m = 0; m < 4; ++m) _Pragma("unroll") for (int n = 0; n < 2; ++n) _Pragma("unroll") for (int k = 0; k < 2; ++k) \
        acc[ai][bj][m][n] = __builtin_amdgcn_mfma_f32_16x16x32_bf16(Bt[n][k], At[m][k], acc[ai][bj][m][n], 0, 0, 0); __builtin_amdgcn_s_setprio(0); } while (0)
#define PG8_WAIT_V(n) asm volatile("s_waitcnt vmcnt(" #n ")" ::: "memory")
#define PG8_WAIT_L(n) asm volatile("s_waitcnt lgkmcnt(" #n ")" ::: "memory")
#define PG8_BAR __builtin_amdgcn_s_barrier()
#define PG8_SCHED __builtin_amdgcn_sched_barrier(0)
    Unit cur, nxt; int ui = 0;
    if (!S.next(0, cur)) return;
    f32x4 acc[2][2][4][2];
#pragma unroll
    for (int a = 0; a < 2; ++a)
#pragma unroll
        for (int b = 0; b < 2; ++b)
#pragma unroll
            for (int m = 0; m < 4; ++m)
#pragma unroll
                for (int n = 0; n < 2; ++n) acc[a][b][m][n] = (f32x4){0.f, 0.f, 0.f, 0.f};
    bf16x8 At[4][2], B0[2][2], B1[2][2];
    const char* cA = (const char*)g.A + (size_t)cur.pm * tstepA; const char* cB = (const char*)g.Bt + (size_t)cur.pn * tstepB;
    PG8_STAGE(PG8_SB(0, 0), cB, voffB); PG8_STAGE(PG8_SB(0, 1), cB + hstepB, voffB); PG8_STAGE(PG8_SA(0, 0), cA, voffA); PG8_STAGE(PG8_SA(0, 1), cA + hstepA, voffA);
    if (wr == 1) PG8_BAR;
    PG8_WAIT_V(2); PG8_BAR;
    PG8_STAGE(PG8_SB(1, 0), cB + kstep, voffB); PG8_STAGE(PG8_SA(1, 0), cA + kstep, voffA); PG8_STAGE(PG8_SB(1, 1), cB + hstepB + kstep, voffB);
    PG8_WAIT_V(6); PG8_BAR;
    for (;;) {
        const bool has_next = S.next(ui + 1, nxt);
        const char* nA = has_next ? (const char*)g.A + (size_t)nxt.pm * tstepA : cA; const char* nB = has_next ? (const char*)g.Bt + (size_t)nxt.pn * tstepB : cB;
        for (int t = 0; t < nt; t += 2) {
            const bool last = (t == nt - 2);
            const char* a1 = cA + (size_t)(t + 1) * kstep;
            const char* a2 = last ? nA : cA + (size_t)(t + 2) * kstep; const char* b2 = last ? nB : cB + (size_t)(t + 2) * kstep;
            const char* a3 = a2 + kstep; const char* b3 = b2 + kstep;
            PG8_LDB(B0, 0, 0); PG8_LDB(B1, 0, 1); PG8_SCHED; PG8_LDA(At, 0, 0); PG8_STAGE(PG8_SA(1, 1), a1 + hstepA, voffA);
            PG8_WAIT_V(8); PG8_WAIT_L(0); PG8_BAR; PG8_MMA(0, 0, At, B0); PG8_MMA(0, 1, At, B1); PG8_BAR; PG8_SCHED;
            PG8_LDA(At, 0, 1); PG8_STAGE(PG8_SB(0, 0), b2, voffB); PG8_STAGE(PG8_SB(0, 1), b2 + hstepB, voffB); PG8_STAGE(PG8_SA(0, 0), a2, voffA);
            PG8_WAIT_V(8); PG8_WAIT_L(0); PG8_BAR; PG8_MMA(1, 0, At, B0); PG8_MMA(1, 1, At, B1); PG8_BAR; PG8_SCHED;
            PG8_LDB(B0, 1, 0); PG8_LDB(B1, 1, 1); PG8_SCHED; PG8_LDA(At, 1, 0); PG8_STAGE(PG8_SA(0, 1), a2 + hstepA, voffA);
            PG8_WAIT_V(8); PG8_WAIT_L(0); PG8_BAR; PG8_MMA(0, 0, At, B0); PG8_MMA(0, 1, At, B1); PG8_BAR; PG8_SCHED;
            PG8_LDA(At, 1, 1); PG8_STAGE(PG8_SB(1, 0), b3, voffB); PG8_STAGE(PG8_SB(1, 1), b3 + hstepB, voffB); PG8_STAGE(PG8_SA(1, 0), a3, voffA);
            PG8_WAIT_V(8); PG8_WAIT_L(0); PG8_BAR; PG8_MMA(1, 0, At, B0); PG8_MMA(1, 1, At, B1); PG8_BAR; PG8_SCHED;
        }
        if constexpr (ALIGN_EPI) { if (wr == 0) PG8_BAR; }
        E(acc, cur, wr, wc, fr, fq);
        if (!has_next) break;
#pragma unroll
        for (int a = 0; a < 2; ++a)
#pragma unroll
            for (int b = 0; b < 2; ++b)
#pragma unroll
                for (int m = 0; m < 4; ++m)
#pragma unroll
                    for (int n = 0; n < 2; ++n) acc[a][b][m][n] = (f32x4){0.f, 0.f, 0.f, 0.f};
        cur = nxt; cA = nA; cB = nB; ++ui;
        if constexpr (ALIGN_EPI) { if (wr == 1) PG8_BAR; }
    }
    PG8_WAIT_V(0);
    if constexpr (!ALIGN_EPI) { if (wr == 0) PG8_BAR; }
    PG8_BAR;
#undef PG8_SA
#undef PG8_SB
#undef PG8_STAGE
#undef PG8_LDA
#undef PG8_LDB
#undef PG8_MMA
#undef PG8_WAIT_V
#undef PG8_WAIT_L
#undef PG8_BAR
#undef PG8_SCHED
}
}

enum { EP_IN = 0, EP_RVT, EP_UPQ, EP_UPK, EP_VT, EP_OUT, EP_FF1, EP_FF2, EP_OUTA, EP_FF2A };

__device__ __forceinline__ void rope8(float (&v)[8], int i0, int half, float invstep, int t) {
    const bool col = i0 >= half; const float pos = (float)(col ? (t & 63) : (t >> 6)); const int j0 = col ? i0 - half : i0;
#pragma unroll
    for (int p = 0; p < 4; ++p) {
        const float inv = fexp2(-(float)(j0 + p) * invstep); const float ang = pos * inv;
        const float s = __sinf(ang), c = __cosf(ang);
        const float x1 = v[2 * p], x2 = v[2 * p + 1];
        v[2 * p] = x1 * c - x2 * s; v[2 * p + 1] = x1 * s + x2 * c;
    }
}
constexpr float L2_10000 = 13.287712379549449f;

struct EpiArgs {
    bf16_t *o0, *o1, *o2, *o3, *o4, *o5;
    float *ssq_q, *ssq_k;
    const float* xin_lat; const float* xin_ctx; float* xout_lat; float* xout_ctx;
    const float* mod;
    int row_off;
};

template <int MODE> struct Epi {
    static constexpr bool F32OUT = (MODE == EP_OUT || MODE == EP_FF2 || MODE == EP_OUTA || MODE == EP_FF2A);
    static constexpr bool PERM = !F32OUT;
    static constexpr bool OPAQUE_K = (MODE == EP_OUTA);
    EpiArgs a;
    __device__ __forceinline__ void operator()(const f32x4 (&acc)[2][2][4][2], const pg8::Unit& u, int wr, int wc, int fr_, int fq_) const {
        const int lane_e = fresh_lane(), fr = lane_e & 15, fq = lane_e >> 4;
        if constexpr (F32OUT) {
            constexpr bool PART = (MODE == EP_OUTA || MODE == EP_FF2A);
            const int goff = (MODE == EP_OUT || MODE == EP_OUTA) ? 2048 : 5120;
            const int row0 = a.row_off + u.pm * 256 + wr * 64 + fr;
            const bool lat = row0 < ML;
            const float* gm = a.mod + (size_t)(lat ? (row0 >> 11) : 8) * 6144 + goff + u.pn * 256 + wc * 32 + fq * 4;
            const size_t rbase = (size_t)(lat ? row0 : row0 - ML) * D + u.pn * 256 + wc * 32 + fq * 4;
            const float* xi = (lat ? a.xin_lat : a.xin_ctx) + rbase;
            float* xo = (lat ? a.xout_lat : a.xout_ctx) + rbase;
            f32x4 gv[2][2];
#pragma unroll
            for (int bj = 0; bj < 2; ++bj)
#pragma unroll
                for (int n = 0; n < 2; ++n) gv[bj][n] = *(const f32x4*)(gm + bj * 128 + n * 16);
            if constexpr (PART) {
#pragma unroll
                for (int ai = 0; ai < 2; ++ai)
#pragma unroll
                    for (int m = 0; m < 4; ++m)
#pragma unroll
                        for (int bj = 0; bj < 2; ++bj)
#pragma unroll
                            for (int n = 0; n < 2; ++n) *(f32x4*)(xo + (size_t)(ai * 128 + m * 16) * D + bj * 128 + n * 16) = gv[bj][n] * acc[ai][bj][m][n];
            } else {
                f32x4 xv[3][2][2];
#pragma unroll
                for (int p = 0; p < 2; ++p)
#pragma unroll
                    for (int bj = 0; bj < 2; ++bj)
#pragma unroll
                        for (int n = 0; n < 2; ++n) xv[p][bj][n] = *(const f32x4*)(xi + (size_t)((p >> 2) * 128 + (p & 3) * 16) * D + bj * 128 + n * 16);
#pragma unroll
                for (int r = 0; r < 8; ++r) {
                    const int ai = r >> 2, m = r & 3;
                    if (r + 2 < 8) {
                        const int r2 = r + 2;
#pragma unroll
                        for (int bj = 0; bj < 2; ++bj)
#pragma unroll
                            for (int n = 0; n < 2; ++n) xv[r2 % 3][bj][n] = *(const f32x4*)(xi + (size_t)((r2 >> 2) * 128 + (r2 & 3) * 16) * D + bj * 128 + n * 16);
                    }
#pragma unroll
                    for (int bj = 0; bj < 2; ++bj)
#pragma unroll
                        for (int n = 0; n < 2; ++n) *(f32x4*)(xo + (size_t)(ai * 128 + m * 16) * D + bj * 128 + n * 16) = xv[r % 3][bj][n] + gv[bj][n] * acc[ai][bj][m][n];
                }
            }
        } else if constexpr (MODE == EP_IN) {
            switch (u.pn) {
                case 0: rows<0>(acc, u, wr, wc, fr, fq); break;
                case 1: rows<1>(acc, u, wr, wc, fr, fq); break;
                case 2: rows<2>(acc, u, wr, wc, fr, fq); break;
                case 3: rows<3>(acc, u, wr, wc, fr, fq); break;
                case 4: rows<4>(acc, u, wr, wc, fr, fq); break;
                default: rows<5>(acc, u, wr, wc, fr, fq); break;
            }
        } else {
            rows<0>(acc, u, wr, wc, fr, fq);
        }
    }
    template <int PN>
    __device__ __forceinline__ void rows(const f32x4 (&acc)[2][2][4][2], const pg8::Unit& u, int wr, int wc, int fr, int fq) const {
        float rcol[2][8];
        if constexpr (MODE == EP_VT) {
#pragma unroll
            for (int bj = 0; bj < 2; ++bj)
#pragma unroll
                for (int e = 0; e < 8; ++e) { const int col = u.pn * 256 + bj * 128 + wc * 32 + fq * 8 + e; const f32x4 s4 = *(const f32x4*)(a.ssq_k + (size_t)col * 4); rcol[bj][e] = rsqrtf(((s4[0] + s4[1]) + (s4[2] + s4[3])) * (1.f / 128.f) + EPS); }
            __builtin_amdgcn_sched_barrier(0);
        }
        float rsr[2][4];
        if constexpr (MODE == EP_UPQ || MODE == EP_UPK) {
            const float* sp = (MODE == EP_UPQ) ? a.ssq_q : a.ssq_k;
            f32x4 s4[2][4];
#pragma unroll
            for (int ai = 0; ai < 2; ++ai)
#pragma unroll
                for (int m = 0; m < 4; ++m) s4[ai][m] = *(const f32x4*)(sp + (size_t)(u.pm * 256 + ai * 128 + wr * 64 + m * 16 + fr) * 4);
#pragma unroll
            for (int ai = 0; ai < 2; ++ai)
#pragma unroll
                for (int m = 0; m < 4; ++m) {
                    const float sm = (s4[ai][m][0] + s4[ai][m][1]) + (s4[ai][m][2] + s4[ai][m][3]);
                    rsr[ai][m] = (MODE == EP_UPQ) ? rsqrtf(sm * (1.f / 256.f) + EPS) * QSCALE : rsqrtf(sm * (1.f / 128.f) + EPS);
                }
            __builtin_amdgcn_sched_barrier(0);
        }
#pragma unroll
        for (int ai = 0; ai < 2; ++ai)
#pragma unroll
            for (int m = 0; m < 4; ++m) {
                const int row = u.pm * 256 + ai * 128 + wr * 64 + m * 16 + fr;
                const bool lat = row < ML; const int t = row & 2047;
                float ssq = 0.f; float rs = 1.f;
                if constexpr (MODE == EP_UPQ || MODE == EP_UPK) rs = rsr[ai][m];
#pragma unroll
                for (int bj = 0; bj < 2; ++bj) {
                    const int cl = bj * 128 + wc * 32 + fq * 8;
                    const int col = u.pn * 256 + cl;
                    float v[8];
#pragma unroll
                    for (int e = 0; e < 4; ++e) { v[e] = acc[ai][bj][m][0][e]; v[4 + e] = acc[ai][bj][m][1][e]; }
                    bf16_t* dst = nullptr;
                    if constexpr (MODE == EP_IN) {
                        if constexpr (PN <= 1) {
                            if (lat) rope8(v, (cl & 63) >> 1, 16, L2_10000 / 16.f, t);
                            if constexpr (PN == 1) {
#pragma unroll
                                for (int e = 0; e < 8; ++e) v[e] *= 0.125f;
                            }
                            dst = (PN == 0 ? a.o0 : a.o1) + (size_t)row * 256 + cl;
                        } else if constexpr (PN == 2) {
#pragma unroll
                            for (int e = 0; e < 8; ++e) v[e] = v[e] / (1.f + __expf(-v[e]));
                            dst = a.o2 + (size_t)row * 256 + cl;
                        } else if constexpr (PN == 3) {
#pragma unroll
                            for (int e = 0; e < 8; ++e) ssq += v[e] * v[e];
                            dst = a.o3 + (size_t)row * 256 + cl;
                        } else if constexpr (PN == 4) {
                            dst = a.o4 + (size_t)row * 256 + cl;
                        } else {
                            if (bj == 0) {
#pragma unroll
                                for (int e = 0; e < 8; ++e) ssq += v[e] * v[e];
                            } else if (cl < 160) { if (lat) rope8(v, (cl - 128) >> 1, 8, L2_10000 / 8.f, t); }
                            dst = a.o5 + (size_t)row * 256 + cl;
                        }
                    } else if constexpr (MODE == EP_RVT) {
                        dst = a.o0 + (size_t)row * MT + col;
                    } else if constexpr (MODE == EP_UPQ) {
                        const int jj = col % 96;
                        if (jj >= 64 && lat) rope8(v, (jj - 64) >> 1, 8, L2_10000 / 8.f, t);
#pragma unroll
                        for (int e = 0; e < 8; ++e) v[e] *= rs;
                        dst = a.o0 + (size_t)row * 768 + col;
                    } else if constexpr (MODE == EP_UPK) {
#pragma unroll
                        for (int e = 0; e < 8; ++e) v[e] *= rs;
                        dst = a.o0 + (size_t)row * 512 + col;
                    } else if constexpr (MODE == EP_VT) {
#pragma unroll
                        for (int e = 0; e < 8; ++e) v[e] *= rcol[bj][e];
                        dst = a.o0 + (size_t)row * MT + col;
                    } else if constexpr (MODE == EP_FF1) {
#pragma unroll
                        for (int e = 0; e < 8; ++e) { const float r = fmaxf(v[e], 0.f); v[e] = r * r; }
                        dst = a.o0 + (size_t)row * FF + col;
                    }
                    u32x4 w; w.x = cvt_pk_bf16(v[0], v[1]); w.y = cvt_pk_bf16(v[2], v[3]); w.z = cvt_pk_bf16(v[4], v[5]); w.w = cvt_pk_bf16(v[6], v[7]);
                    *(u32x4*)dst = w;
                }
                if constexpr (MODE == EP_IN && (PN == 3 || PN == 5)) {
                    ssq = xsum16(ssq); ssq = xsum32(ssq);
                    if (fq == 0) (PN == 3 ? a.ssq_q : a.ssq_k)[(size_t)row * 4 + wc] = ssq;
                }
                __builtin_amdgcn_sched_barrier(0);
            }
    }
};

template <class RowMap>
__device__ __forceinline__ void transpose_item(const float* W, int N, bf16_t* WT, int ldt, const float* kscale, LAS float* scr, int item, int lane, RowMap rm) {
    const int nblk = N / 32, kb = item / nblk, nb = item % nblk, k0 = 64 * kb, n0 = 32 * nb;
#pragma unroll
    for (int i = 0; i < 32; ++i) { const int kk = 2 * i + (lane >> 5); float w = *(const __attribute__((address_space(1))) float*)(W + (size_t)(k0 + kk) * N + n0 + (lane & 31)); if (kscale) w *= kscale[k0 + kk]; scr[kk * 33 + (lane & 31)] = w; }
    asm volatile("s_waitcnt lgkmcnt(0)" ::: "memory");
    const int c = lane & 7;
#pragma unroll
    for (int j = 0; j < 4; ++j) { const int n = (lane >> 3) + 8 * j; const LAS float* s = scr + (8 * c) * 33 + n;
        u32x4 o; o.x = cvt_pk_bf16(s[0 * 33], s[1 * 33]); o.y = cvt_pk_bf16(s[2 * 33], s[3 * 33]); o.z = cvt_pk_bf16(s[4 * 33], s[5 * 33]); o.w = cvt_pk_bf16(s[6 * 33], s[7 * 33]);
        *(u32x4*)(WT + (size_t)rm(n0 + n) * ldt + k0 + 8 * c) = o; }
    asm volatile("s_waitcnt lgkmcnt(0)" ::: "memory");
}
struct MapId { __device__ __forceinline__ int operator()(int n) const { return n; } };
struct MapIn { __device__ __forceinline__ int operator()(int n) const {
    if (n < 512) { const int i = n & 63; return (n & ~63) + (i < 32 ? 2 * i : 2 * (i - 32) + 1); }
    if (n < 768) return 1536 + (n - 512);
    if (n < 1024) return 512 + (n - 768);
    if (n < 1280) return 768 + (n - 1024);
    if (n < 1408) return 1280 + (n - 1280);
    if (n < 1440) { const int i = n - 1408; return 1408 + (i < 16 ? 2 * i : 2 * (i - 16) + 1); }
    return 1024 + (n - 1440);
} };
struct MapUq { __device__ __forceinline__ int operator()(int n) const { const int h = n / 96, j = n - h * 96; if (j < 64) return n; const int r = j - 64; return h * 96 + 64 + (r < 16 ? 2 * r : 2 * (r - 16) + 1); } };
struct MapUkv { __device__ __forceinline__ int operator()(int n) const { const int h = n >> 7, j = n & 127; return j < 64 ? h * 64 + j : 512 + h * 64 + (j - 64); } };


struct TItem { const float* W; bf16_t* WT; const float* kscale; int N, ldt, map, r; };
__device__ __forceinline__ int map_row(int map, int n) {
    if (map == 1) return MapIn()(n);
    if (map == 2) return MapUq()(n);
    if (map == 3) return MapUkv()(n);
    return n;
}
__device__ __forceinline__ void titem_issue(const TItem& t, float (&reg)[32], int lane) {
    const int nblk = t.N / 32, kb = t.r / nblk, nb = t.r - kb * nblk, k0 = 64 * kb, n0 = 32 * nb;
    const float* p = t.W + (size_t)(k0 + (lane >> 5)) * t.N + n0 + (lane & 31);
    const size_t step = (size_t)2 * t.N;
#pragma unroll
    for (int i = 0; i < 32; ++i) { reg[i] = *(const __attribute__((address_space(1))) float*)p; p += step; if ((i & 7) == 7) __builtin_amdgcn_sched_barrier(0); }
}
__device__ __forceinline__ void titem_finish(const TItem& t, const float (&reg)[32], LAS float* scr, int lane) {
    const int nblk = t.N / 32, kb = t.r / nblk, nb = t.r - kb * nblk, k0 = 64 * kb, n0 = 32 * nb;
#pragma unroll
    for (int i = 0; i < 32; ++i) { const int kk = 2 * i + (lane >> 5); scr[kk * 33 + (lane & 31)] = reg[i]; }
    asm volatile("s_waitcnt lgkmcnt(0)" ::: "memory");
    const int c = lane & 7;
    f32x4 ks0 = (f32x4){1.f, 1.f, 1.f, 1.f}, ks1 = ks0;
    if (t.kscale) { ks0 = *(const f32x4*)(t.kscale + k0 + 8 * c); ks1 = *(const f32x4*)(t.kscale + k0 + 8 * c + 4); }
#pragma unroll
    for (int j = 0; j < 4; ++j) { const int n = (lane >> 3) + 8 * j; const LAS float* sp = scr + (8 * c) * 33 + n;
        u32x4 o; o.x = cvt_pk_bf16(sp[0 * 33] * ks0[0], sp[1 * 33] * ks0[1]); o.y = cvt_pk_bf16(sp[2 * 33] * ks0[2], sp[3 * 33] * ks0[3]);
        o.z = cvt_pk_bf16(sp[4 * 33] * ks1[0], sp[5 * 33] * ks1[1]); o.w = cvt_pk_bf16(sp[6 * 33] * ks1[2], sp[7 * 33] * ks1[3]);
        *(u32x4*)(t.WT + (size_t)map_row(t.map, n0 + n) * t.ldt + k0 + 8 * c) = o; }
    asm volatile("s_waitcnt lgkmcnt(0)" ::: "memory");
}

struct Params { const float* in[20]; float* out; unsigned char* ws; };

typedef const __attribute__((address_space(4))) unsigned long long* kaptr_t;
__device__ __forceinline__ unsigned long long karg_raw(int i) { kaptr_t ka = (kaptr_t)__builtin_amdgcn_kernarg_segment_ptr(); asm volatile("" : "+s"(ka)); return ka[i]; }
__device__ __forceinline__ const float* karg(int i) { return (const float*)karg_raw(i); }
__device__ __forceinline__ float* karg_out() { return (float*)karg_raw(20); }
__device__ __forceinline__ unsigned char* karg_ws() { return (unsigned char*)karg_raw(21); }

__device__ __forceinline__ void prologue(LAS unsigned char* lds, int tid, int wave, int lane, int G) {
    unsigned char* ws = karg_ws();
    const float* c_in = karg(1); const float* cctx = karg(3); const float* w_ada = karg(4); const float* b_ada = karg(5);
    if (blockIdx.x < 192) {
        const int l = blockIdx.x / 96, cb = blockIdx.x % 96;
        LAS float* sv = (LAS float*)lds;
        LAS float* red = (LAS float*)(lds + 40960);
        {
            float cv[18];
#pragma unroll
            for (int j = 0; j < 18; ++j) { const int i = tid + j * 512; cv[j] = *(const __attribute__((address_space(1))) float*)(i < 8192 ? c_in + i : cctx + (i - 8192)); }
#pragma unroll
            for (int j = 0; j < 18; ++j) sv[tid + j * 512] = cv[j] / (1.f + __expf(-cv[j]));
        }
        __syncthreads();
        float acc[9];
#pragma unroll
        for (int r = 0; r < 9; ++r) acc[r] = 0.f;
        const float* wp = w_ada + (size_t)l * 1024 * 6144 + cb * 64 + lane;
        const int k0 = wave * 128;
#pragma unroll 32
        for (int k = 0; k < 128; ++k) {
            const float wv = *(const __attribute__((address_space(1))) float*)(wp + (size_t)(k0 + k) * 6144);
#pragma unroll
            for (int r = 0; r < 9; ++r) acc[r] += sv[r * 1024 + k0 + k] * wv;
        }
#pragma unroll
        for (int r = 0; r < 9; ++r) red[(wave * 9 + r) * 64 + lane] = acc[r];
        __syncthreads();
        for (int i = tid; i < 576; i += 512) {
            const int r = i >> 6, ln = i & 63; float s = 0.f;
#pragma unroll
            for (int w = 0; w < 8; ++w) s += red[(w * 9 + r) * 64 + ln];
            const int n = cb * 64 + ln;
            ((float*)(ws + WS_MOD))[(size_t)(l * 9 + r) * 6144 + n] = s + b_ada[l * 6144 + n];
        }
        __syncthreads();
    }
    { const f32x4* src = (const f32x4*)karg(2); f32x4* dst = (f32x4*)(ws + WS_H); for (int i = blockIdx.x * 512 + tid; i < MC * D / 4; i += G * 512) dst[i] = src[i]; }
    LAS float* scr = (LAS float*)(lds + wave * 16384);
    const int gw = blockIdx.x * 8 + wave, NGW = G * 8;
    constexpr int I_IN = 16 * 53, I_UQ = 4 * 24, I_UKV = 2 * 32, I_OUT = 12 * 32, I_F1 = 16 * 128, I_F2 = 64 * 32, I_POOL = 512, I_ZERO = 8;
    constexpr int I_LAYER = I_IN + I_UQ + I_UKV + I_OUT + I_F1 + I_F2 + I_POOL + I_ZERO;
#define DECODE_T(it_, t_, ok_) do { ok_ = false; if ((it_) < 2 * I_LAYER) { const int l_ = (it_) / I_LAYER; int r_ = (it_) - l_ * I_LAYER; \
        if (r_ < I_IN) { t_ = TItem{karg(7) + (size_t)l_ * 1024 * INW, (bf16_t*)(ws + WS_WIN) + (size_t)l_ * 1792 * 1024, nullptr, INW, 1024, 1, r_}; ok_ = true; } \
        else if ((r_ -= I_IN) < I_UQ) { t_ = TItem{karg(9) + (size_t)l_ * 256 * 768, (bf16_t*)(ws + WS_WUQ) + (size_t)l_ * 768 * 256, karg(8) + l_ * 256, 768, 256, 2, r_}; ok_ = true; } \
        else if ((r_ -= I_UQ) < I_UKV) { t_ = TItem{karg(11) + (size_t)l_ * 128 * 1024, (bf16_t*)(ws + WS_WUKV) + (size_t)l_ * 1024 * 256, karg(10) + l_ * 128, 1024, 256, 3, r_}; ok_ = true; } \
        else if ((r_ -= I_UKV) < I_OUT) { t_ = TItem{karg(15) + (size_t)l_ * 1024 * 1024, (bf16_t*)(ws + WS_WOUT) + (size_t)l_ * 1024 * 1024, nullptr, 1024, 1024, 0, r_}; ok_ = true; } \
        else if ((r_ -= I_OUT) < I_F1) { t_ = TItem{karg(17) + (size_t)l_ * 1024 * 4096, (bf16_t*)(ws + WS_WFF1) + (size_t)l_ * 4096 * 1024, nullptr, 4096, 1024, 0, r_}; ok_ = true; } \
        else if ((r_ -= I_F1) < I_F2) { t_ = TItem{karg(18) + (size_t)l_ * 4096 * 1024, (bf16_t*)(ws + WS_WFF2) + (size_t)l_ * 1024 * 4096, nullptr, 1024, 4096, 0, r_}; ok_ = true; } } } while (0)
    TItem tc{}, tn{}; bool okc, okn; float rc[32], rn[32];
    DECODE_T(gw, tc, okc);
    if (okc) titem_issue(tc, rc, lane);
    for (int it = gw; it < 2 * I_LAYER; it += NGW) {
        DECODE_T(it + NGW, tn, okn);
        if (okn) titem_issue(tn, rn, lane);
        if (okc) {
            titem_finish(tc, rc, scr, lane);
#pragma unroll
            for (int i = 0; i < 32; ++i) rc[i] = rn[i];
            tc = tn; okc = okn;
            continue;
        }
#pragma unroll
        for (int i = 0; i < 32; ++i) rc[i] = rn[i];
        tc = tn; okc = okn;
        const int l = it / I_LAYER; int r = it - l * I_LAYER - (I_IN + I_UQ + I_UKV + I_OUT + I_F1 + I_F2);
        bf16_t* win = (bf16_t*)(ws + WS_WIN) + (size_t)l * 1792 * 1024;
        bf16_t* wukv = (bf16_t*)(ws + WS_WUKV) + (size_t)l * 1024 * 256;
        bf16_t* wout = (bf16_t*)(ws + WS_WOUT) + (size_t)l * 1024 * 1024;
        if (r < I_POOL) {
            const int g = r >> 7, nb = (r >> 3) & 15, cc = r & 7, n = nb * 64 + lane;
            const float* wpool = karg(13) + (size_t)(l * 4 + g) * 4096 + (size_t)cc * 8 * 64; const float psd = karg(14)[l * 256 + g * 64 + lane];
#pragma unroll
            for (int j = 0; j < 8; ++j) scr[lane * 8 + j] = wpool[j * 64 + lane] * psd;
            asm volatile("s_waitcnt lgkmcnt(0)" ::: "memory");
            const float* wo = karg(15) + (size_t)l * 1024 * 1024 + (size_t)(768 + g * 64) * 1024 + n;
            float acc[8];
#pragma unroll
            for (int j = 0; j < 8; ++j) acc[j] = 0.f;
#pragma unroll 1
            for (int dh = 0; dh < 4; ++dh) {
                float wv[16];
#pragma unroll
                for (int d = 0; d < 16; ++d) wv[d] = wo[(size_t)(dh * 16 + d) * 1024];
#pragma unroll
                for (int d = 0; d < 16; ++d) {
                    const f32x4 s0 = *(const LAS f32x4*)(scr + (dh * 16 + d) * 8), s1 = *(const LAS f32x4*)(scr + (dh * 16 + d) * 8 + 4);
                    acc[0] += s0[0] * wv[d]; acc[1] += s0[1] * wv[d]; acc[2] += s0[2] * wv[d]; acc[3] += s0[3] * wv[d];
                    acc[4] += s1[0] * wv[d]; acc[5] += s1[1] * wv[d]; acc[6] += s1[2] * wv[d]; acc[7] += s1[3] * wv[d];
                }
            }
            u32x4 o; o.x = cvt_pk_bf16(acc[0], acc[1]); o.y = cvt_pk_bf16(acc[2], acc[3]); o.z = cvt_pk_bf16(acc[4], acc[5]); o.w = cvt_pk_bf16(acc[6], acc[7]);
            *(u32x4*)(wout + (size_t)n * 1024 + 768 + g * 64 + cc * 8) = o;
            asm volatile("s_waitcnt lgkmcnt(0)" ::: "memory");
            continue;
        } r -= I_POOL;
        {
            const u32x4 z = (u32x4){0u, 0u, 0u, 0u};
            u32x4* a = (u32x4*)(win + (size_t)1440 * 1024);
            for (int i = r * 64 + lane; i < 12288; i += 8 * 64) a[i] = z;
            for (int i = r * 64 + lane; i < 1024 * 16; i += 8 * 64) { const int row = i >> 4, ch = i & 15; *(u32x4*)(wukv + (size_t)row * 256 + 128 + ch * 8) = z; }
        }
    }
}

__device__ __forceinline__ void norm_phase(const float* src_lat, float* src_ctx, const float* part, const float* gain, const float* mod, int sh_off, int sc_off, bf16_t* dst, int row_lo, int nrows, int wave, int lane, int G) {
    int row = row_lo + fresh_bx() * 8 + wave; const int step = G * 8;
    f32x4 v[4], vn[4], vnn[4], c1[4], c1n[4], c1nn[4], c0[4], c0n[4], c0nn[4], g4[4];
#pragma unroll
    for (int j = 0; j < 4; ++j) g4[j] = *(const __attribute__((address_space(1))) f32x4*)(gain + (64 * j + lane) * 4);
#define NORM_LD(dst_, sc_, sh_, r_) do { if ((r_) < nrows) { const float* src_ = (r_) < ML ? src_lat + (size_t)(r_) * D : src_ctx + (size_t)((r_) - ML) * D; \
        const float* mr_ = mod + (size_t)((r_) < ML ? ((r_) >> 11) : 8) * 6144; \
        _Pragma("unroll") for (int j_ = 0; j_ < 4; ++j_) { dst_[j_] = *(const __attribute__((address_space(1))) f32x4*)(src_ + (64 * j_ + lane) * 4); \
            sc_[j_] = *(const __attribute__((address_space(1))) f32x4*)(mr_ + sc_off + (64 * j_ + lane) * 4); sh_[j_] = *(const __attribute__((address_space(1))) f32x4*)(mr_ + sh_off + (64 * j_ + lane) * 4); } } } while (0)
    NORM_LD(v, c1, c0, row); NORM_LD(vn, c1n, c0n, row + step);
    while (row < nrows) {
        NORM_LD(vnn, c1nn, c0nn, row + 2 * step);
        const bool lat = row < ML;
        float ss = 0.f;
#pragma unroll
        for (int j = 0; j < 4; ++j) {
            if (part && !lat) {
#pragma unroll
                for (int ks = 0; ks < 4; ++ks) v[j] += *(const f32x4*)(part + ((size_t)ks * MC + (row - ML)) * D + (64 * j + lane) * 4);
                *(f32x4*)(src_ctx + (size_t)(row - ML) * D + (64 * j + lane) * 4) = v[j];
            }
            ss += (v[j][0] * v[j][0] + v[j][1] * v[j][1]) + (v[j][2] * v[j][2] + v[j][3] * v[j][3]);
        }
        const float rstd = rsqrtf(wave_sum(ss) * (1.f / D) + EPS);
#pragma unroll
        for (int j = 0; j < 4; ++j) {
            const int c = (64 * j + lane) * 4;
            const f32x4 y = v[j] * rstd * g4[j] * (c1[j] + 1.f) + c0[j];
            u32x2 w; w.x = cvt_pk_bf16(y[0], y[1]); w.y = cvt_pk_bf16(y[2], y[3]);
            *(u32x2*)(dst + (size_t)row * D + c) = w;
        }
#pragma unroll
        for (int j = 0; j < 4; ++j) { v[j] = vn[j]; vn[j] = vnn[j]; c1[j] = c1n[j]; c1n[j] = c1nn[j]; c0[j] = c0n[j]; c0n[j] = c0nn[j]; }
        row += step;
    }
#undef NORM_LD
}

__device__ __forceinline__ bf16x8 pack8(const float* p) {
    u32x4 w; w.x = cvt_pk_bf16(p[0], p[1]); w.y = cvt_pk_bf16(p[2], p[3]); w.z = cvt_pk_bf16(p[4], p[5]); w.w = cvt_pk_bf16(p[6], p[7]);
    return __builtin_bit_cast(bf16x8, w);
}
__device__ __forceinline__ bf16x8 ldv8(const LAS unsigned char* p0, const LAS unsigned char* p1) {
    const u32x2 lo = *(const LAS u32x2*)p0, hi = *(const LAS u32x2*)p1;
    u32x4 w; w.x = lo.x; w.y = lo.y; w.z = hi.x; w.w = hi.y; return __builtin_bit_cast(bf16x8, w);
}

constexpr int KSTR_R = 144, KBUF_R = 64 * KSTR_R;
__device__ __forceinline__ void ret_unit(LAS unsigned char* lds, const bf16_t* RQ, const bf16_t* RK, const bf16_t* RVT, const bf16_t* RG, bf16_t* MIX,
                                         int b, int h, int qb, bool ctxq, float lf, float lb, int tid, int wave, int lane) {
    const int q = lane & 31, hi = lane >> 5;
    const int nct = ctxq ? 0 : 4, ntile = ctxq ? 4 : 36;
    const int ctxbase = ML + b * CTX, selfbase = ctxq ? ctxbase : b * SEQ;
    const int tq = qb * 256 + wave * 32 + q, qrow = selfbase + tq;
    bf16x8 qf[4];
#pragma unroll
    for (int ks = 0; ks < 4; ++ks) qf[ks] = *(const bf16x8*)(RQ + (size_t)qrow * 256 + h * 64 + ks * 16 + hi * 8);
    f32x16 o0, o1;
#pragma unroll
    for (int r = 0; r < 16; ++r) { o0[r] = 0.f; o1[r] = 0.f; }
    float cf[2][16], cb[2][16];
#pragma unroll
    for (int kb = 0; kb < 2; ++kb)
#pragma unroll
        for (int r = 0; r < 16; ++r) { const int key = 32 * kb + (r & 3) + 8 * (r >> 2) + 4 * hi; cf[kb][r] = fexp2(lf * (float)(63 - key)); cb[kb][r] = fexp2(lb * (float)key); }
    LAS unsigned char* Kt = lds; LAS unsigned char* Vt = lds + 2 * KBUF_R;
    const int lrow = tid >> 3, lpart = tid & 7;
    u32x4 kreg, vreg;
    { const int r0 = nct ? ctxbase : selfbase;
      kreg = gld16(RK + (size_t)(r0 + lrow) * 256 + h * 64 + lpart * 8); vreg = gld16(RVT + (size_t)(h * 64 + lrow) * MT + r0 + lpart * 8); }
#pragma unroll 1
    for (int kt = 0; kt < ntile; ++kt) {
        const int buf = kt & 1;
        *(LAS u32x4*)(Kt + buf * KBUF_R + lrow * KSTR_R + lpart * 16) = kreg; *(LAS u32x4*)(Vt + buf * KBUF_R + lrow * KSTR_R + lpart * 16) = vreg;
        __syncthreads();
        if (kt + 1 < ntile) { const int k1 = kt + 1; const int r0 = k1 < nct ? ctxbase + 64 * k1 : selfbase + 64 * (k1 - nct);
            kreg = gld16(RK + (size_t)(r0 + lrow) * 256 + h * 64 + lpart * 8); vreg = gld16(RVT + (size_t)(h * 64 + lrow) * MT + r0 + lpart * 8); }
        const LAS unsigned char* kb_ = Kt + buf * KBUF_R; const LAS unsigned char* vb_ = Vt + buf * KBUF_R;
        const bool isctx = kt < nct;
        const int kpos0 = isctx ? 64 * kt : 64 * (kt - nct);
        const int tw0 = qb * 256 + wave * 32;
        const bool fwd = isctx || (kpos0 + 63 <= tw0), bwd = isctx || (kpos0 > tw0 + 31), diag = !(fwd || bwd);
        const float rf = fwd ? fexp2(lf * (float)(tq - kpos0 - 63 + (isctx ? 256 : 0))) : 0.f;
        const float rb = bwd ? fexp2(lb * (float)(kpos0 - tq + (isctx ? 2048 : 0))) : 0.f;
#pragma unroll
        for (int kb = 0; kb < 2; ++kb) {
            f32x16 s;
#pragma unroll
            for (int r = 0; r < 16; ++r) s[r] = 0.f;
#pragma unroll
            for (int ks = 0; ks < 4; ++ks) { const bf16x8 af = *(const LAS bf16x8*)(kb_ + (32 * kb + q) * KSTR_R + (ks * 16 + hi * 8) * 2); s = __builtin_amdgcn_mfma_f32_32x32x16_bf16(af, qf[ks], s, 0, 0, 0); }
            float pv[16];
            if (diag) {
#pragma unroll
                for (int r = 0; r < 16; ++r) {
                    const int key = kpos0 + 32 * kb + (r & 3) + 8 * (r >> 2) + 4 * hi;
                    const int dd = tq - key;
                    pv[r] = s[r] * fexp2((dd >= 0 ? lf : -lb) * (float)dd);
                }
            } else {
#pragma unroll
                for (int r = 0; r < 16; ++r) pv[r] = s[r] * (rf * cf[kb][r] + rb * cb[kb][r]);
            }
            const bf16x8 pa0 = pack8(pv), pa1 = pack8(pv + 8);
#pragma unroll
            for (int sl = 0; sl < 2; ++sl) {
                const int base = 32 * kb + 16 * sl + 4 * hi;
                const bf16x8 v0 = ldv8(vb_ + q * KSTR_R + base * 2, vb_ + q * KSTR_R + (base + 8) * 2);
                const bf16x8 v1 = ldv8(vb_ + (32 + q) * KSTR_R + base * 2, vb_ + (32 + q) * KSTR_R + (base + 8) * 2);
                o0 = __builtin_amdgcn_mfma_f32_32x32x16_bf16(v0, sl ? pa1 : pa0, o0, 0, 0, 0);
                o1 = __builtin_amdgcn_mfma_f32_32x32x16_bf16(v1, sl ? pa1 : pa0, o1, 0, 0, 0);
            }
        }
    }
    __syncthreads();
    float sum = 0.f;
#pragma unroll
    for (int r = 0; r < 16; ++r) sum += o0[r] + o1[r];
    sum = xsum32(sum);
    const float mu = sum * (1.f / 64.f);
    float var = 0.f;
#pragma unroll
    for (int r = 0; r < 16; ++r) { const float a0 = o0[r] - mu, a1 = o1[r] - mu; var += a0 * a0 + a1 * a1; }
    var = xsum32(var);
    const float rs = rsqrtf(var * (1.f / 64.f) + EPS);
    LAS unsigned char* stg = lds + wave * 4608;
#pragma unroll
    for (int db = 0; db < 2; ++db)
#pragma unroll
        for (int rg = 0; rg < 4; ++rg) {
            const int d0 = 32 * db + 8 * rg + 4 * hi;
            const u32x2 g2 = *(const u32x2*)(RG + (size_t)qrow * 256 + h * 64 + d0);
            float y[4];
#pragma unroll
            for (int e = 0; e < 4; ++e) y[e] = ((db ? o1[4 * rg + e] : o0[4 * rg + e]) - mu) * rs;
            y[0] *= bf_lo(g2.x); y[1] *= bf_hi(g2.x); y[2] *= bf_lo(g2.y); y[3] *= bf_hi(g2.y);
            u32x2 w; w.x = cvt_pk_bf16(y[0], y[1]); w.y = cvt_pk_bf16(y[2], y[3]);
            *(LAS u32x2*)(stg + q * 136 + d0 * 2) = w;
        }
    asm volatile("s_waitcnt lgkmcnt(0)" ::: "memory");
    {
        const int rowb = selfbase + qb * 256 + wave * 32;
#pragma unroll
        for (int ps = 0; ps < 4; ++ps) {
            const int r = ps * 8 + (lane >> 3), ch = lane & 7;
            const u32x2 lo = *(const LAS u32x2*)(stg + r * 136 + ch * 16), hi2 = *(const LAS u32x2*)(stg + r * 136 + ch * 16 + 8);
            u32x4 w; w.x = lo.x; w.y = lo.y; w.z = hi2.x; w.w = hi2.y;
            *(u32x4*)(MIX + (size_t)(rowb + r) * D + h * 64 + ch * 8) = w;
        }
    }
    __syncthreads();
}

constexpr int KSTR_A = 208, KBUF_A = 64 * KSTR_A, VSTR_A = 144, VBUF_A = 64 * VSTR_A;
constexpr float ATT_THR = 8.f;
__device__ __forceinline__ void attn_tile(const LAS unsigned char* kb_, const LAS unsigned char* vb_, const bf16x8 (&qf)[6], f32x16& o0, f32x16& o1, f32x16& negm, float& lsum, bool first, int q, int hi) {
    f32x16 s0, s1;
#pragma unroll
    for (int ks = 0; ks < 6; ++ks) {
        const bf16x8 a0 = *(const LAS bf16x8*)(kb_ + q * KSTR_A + (ks * 16 + hi * 8) * 2);
        const bf16x8 a1 = *(const LAS bf16x8*)(kb_ + (32 + q) * KSTR_A + (ks * 16 + hi * 8) * 2);
        if (ks == 0) { s0 = __builtin_amdgcn_mfma_f32_32x32x16_bf16(a0, qf[0], negm, 0, 0, 0); s1 = __builtin_amdgcn_mfma_f32_32x32x16_bf16(a1, qf[0], negm, 0, 0, 0); }
        else { s0 = __builtin_amdgcn_mfma_f32_32x32x16_bf16(a0, qf[ks], s0, 0, 0, 0); s1 = __builtin_amdgcn_mfma_f32_32x32x16_bf16(a1, qf[ks], s1, 0, 0, 0); }
    }
    float mx = s0[0];
#pragma unroll
    for (int r = 1; r < 16; ++r) mx = fmaxf(mx, s0[r]);
#pragma unroll
    for (int r = 0; r < 16; ++r) mx = fmaxf(mx, s1[r]);
    mx = xmax32(mx);
    if (first || __builtin_amdgcn_ballot_w64(mx > ATT_THR) != 0ull) {
        const float d = first ? mx : fmaxf(mx, 0.f);
        const float alpha = first ? 0.f : fexp2(-d);
#pragma unroll
        for (int r = 0; r < 16; ++r) { o0[r] *= alpha; o1[r] *= alpha; s0[r] -= d; s1[r] -= d; negm[r] -= d; }
        lsum *= alpha;
    }
    float p0[16], p1[16]; float rsum = 0.f;
#pragma unroll
    for (int r = 0; r < 16; ++r) { p0[r] = fexp2(s0[r]); p1[r] = fexp2(s1[r]); rsum += p0[r] + p1[r]; }
    lsum += rsum;
#pragma unroll
    for (int kb = 0; kb < 2; ++kb) {
        const bf16x8 pa0 = pack8(kb ? p1 : p0), pa1 = pack8((kb ? p1 : p0) + 8);
#pragma unroll
        for (int sl = 0; sl < 2; ++sl) {
            const int base = 32 * kb + 16 * sl + 4 * hi;
            const bf16x8 v0 = ldv8(vb_ + q * VSTR_A + base * 2, vb_ + q * VSTR_A + (base + 8) * 2);
            const bf16x8 v1 = ldv8(vb_ + (32 + q) * VSTR_A + base * 2, vb_ + (32 + q) * VSTR_A + (base + 8) * 2);
            o0 = __builtin_amdgcn_mfma_f32_32x32x16_bf16(v0, sl ? pa1 : pa0, o0, 0, 0, 0);
            o1 = __builtin_amdgcn_mfma_f32_32x32x16_bf16(v1, sl ? pa1 : pa0, o1, 0, 0, 0);
        }
    }
}
__device__ __forceinline__ void attn_unit(LAS unsigned char* lds, const bf16_t* Q, const bf16_t* KN, const bf16_t* CKV, const bf16_t* VT, bf16_t* MIX,
                                          int b, int h, int qb, bool ctxq, int tid, int wave, int lane) {
    const int q = lane & 31, hi = lane >> 5;
    const int nct = ctxq ? 0 : 4, ntile = ctxq ? 4 : 36;
    const int ctxbase = ML + b * CTX, selfbase = ctxq ? ctxbase : b * SEQ;
    const int qrow = selfbase + qb * 256 + wave * 32 + q;
    bf16x8 qf[6];
#pragma unroll
    for (int ks = 0; ks < 6; ++ks) qf[ks] = *(const bf16x8*)(Q + (size_t)qrow * 768 + h * 96 + ks * 16 + hi * 8);
    f32x16 o0, o1;
#pragma unroll
    for (int r = 0; r < 16; ++r) { o0[r] = 0.f; o1[r] = 0.f; }
    float lsum = 0.f;
    f32x16 negm;
#pragma unroll
    for (int r = 0; r < 16; ++r) negm[r] = 0.f;
    LAS unsigned char* Kt = lds; LAS unsigned char* Vt = lds + 2 * KBUF_A;
    const int lrow = tid >> 3, lpart = tid & 7, prow = (tid & 255) >> 2, ppart = tid & 3;
    const bool pth = tid < 256;
    const bf16_t* kp = KN + (size_t)lrow * 512 + h * 64 + lpart * 8;
    const bf16_t* pp = CKV + (size_t)prow * 256 + 128 + ppart * 8;
    const bf16_t* vp = VT + (size_t)(h * 64 + lrow) * MT + lpart * 8;
    LAS unsigned char* kw = Kt + lrow * KSTR_A + lpart * 16; LAS unsigned char* pw = Kt + prow * KSTR_A + 128 + ppart * 16; LAS unsigned char* vw = Vt + lrow * VSTR_A + lpart * 16;
#define ATT_ROW0(k1) ((k1) < nct ? ctxbase + 64 * (k1) : selfbase + 64 * ((k1) - nct))
    u32x4 kA, pA, vA, kB, pB, vB;
    { const int r0 = ATT_ROW0(0); kA = gld16(kp + (size_t)r0 * 512); pA = gld16(pp + (size_t)r0 * 256); vA = gld16(vp + r0); }
    { const int r0 = ATT_ROW0(1); kB = gld16(kp + (size_t)r0 * 512); pB = gld16(pp + (size_t)r0 * 256); vB = gld16(vp + r0); }
#pragma unroll 1
    for (int kt = 0; kt < ntile; kt += 2) {
        *(LAS u32x4*)kw = kA; if (pth) *(LAS u32x4*)pw = pA; *(LAS u32x4*)vw = vA;
        __syncthreads();
        if (kt + 2 < ntile) { const int r0 = ATT_ROW0(kt + 2); kA = gld16(kp + (size_t)r0 * 512); pA = gld16(pp + (size_t)r0 * 256); vA = gld16(vp + r0); }
        attn_tile(Kt, Vt, qf, o0, o1, negm, lsum, kt == 0, q, hi);
        *(LAS u32x4*)(kw + KBUF_A) = kB; if (pth) *(LAS u32x4*)(pw + KBUF_A) = pB; *(LAS u32x4*)(vw + VBUF_A) = vB;
        __syncthreads();
        if (kt + 3 < ntile) { const int r0 = ATT_ROW0(kt + 3); kB = gld16(kp + (size_t)r0 * 512); pB = gld16(pp + (size_t)r0 * 256); vB = gld16(vp + r0); }
        attn_tile(Kt + KBUF_A, Vt + VBUF_A, qf, o0, o1, negm, lsum, false, q, hi);
    }
#undef ATT_ROW0
    __syncthreads();
    const float ltot = xsum32(lsum);
    const float inv = 1.f / ltot;
    LAS unsigned char* stg = lds + wave * 4608;
#pragma unroll
    for (int db = 0; db < 2; ++db)
#pragma unroll
        for (int rg = 0; rg < 4; ++rg) {
            const int d0 = 32 * db + 8 * rg + 4 * hi;
            float y[4];
#pragma unroll
            for (int e = 0; e < 4; ++e) y[e] = (db ? o1[4 * rg + e] : o0[4 * rg + e]) * inv;
            u32x2 w; w.x = cvt_pk_bf16(y[0], y[1]); w.y = cvt_pk_bf16(y[2], y[3]);
            *(LAS u32x2*)(stg + q * 136 + d0 * 2) = w;
        }
    asm volatile("s_waitcnt lgkmcnt(0)" ::: "memory");
    {
        const int rowb = selfbase + qb * 256 + wave * 32;
#pragma unroll
        for (int ps = 0; ps < 4; ++ps) {
            const int r = ps * 8 + (lane >> 3), ch = lane & 7;
            const u32x2 lo = *(const LAS u32x2*)(stg + r * 136 + ch * 16), hi2 = *(const LAS u32x2*)(stg + r * 136 + ch * 16 + 8);
            u32x4 w; w.x = lo.x; w.y = lo.y; w.z = hi2.x; w.w = hi2.y;
            *(u32x4*)(MIX + (size_t)(rowb + r) * D + 256 + h * 64 + ch * 8) = w;
        }
    }
    __syncthreads();
}

template <int W>
__device__ __forceinline__ void pool_rows(const bf16_t* U, bf16_t* MIX, int row, int c0) {
    int t, L;
    if (row < ML) { t = row & 2047; L = SEQ; } else { t = (row - ML) & 255; L = CTX; }
    const int base = row - t, lo = t - W / 2;
    u32x4 v[W];
#pragma unroll
    for (int k = 0; k < W; ++k) { int pos = lo + k; pos = pos < 0 ? 0 : (pos > L - 1 ? L - 1 : pos); v[k] = gld16(U + (size_t)(base + pos) * 256 + c0); }
    const u32x4 me = gld16(U + (size_t)row * 256 + c0);
    float s[8];
#pragma unroll
    for (int e = 0; e < 8; ++e) s[e] = 0.f;
#pragma unroll
    for (int k = 0; k < W; ++k) {
        const int pos = lo + k; const float m = (pos >= 0 && pos < L) ? 1.f : 0.f;
        s[0] += m * bf_lo(v[k].x); s[1] += m * bf_hi(v[k].x); s[2] += m * bf_lo(v[k].y); s[3] += m * bf_hi(v[k].y);
        s[4] += m * bf_lo(v[k].z); s[5] += m * bf_hi(v[k].z); s[6] += m * bf_lo(v[k].w); s[7] += m * bf_hi(v[k].w);
    }
    const int hi_ = (lo + W > L) ? L : lo + W, lo_ = lo < 0 ? 0 : lo;
    const float inv = 1.f / (float)(hi_ - lo_);
    float y[8];
    y[0] = s[0] * inv - bf_lo(me.x); y[1] = s[1] * inv - bf_hi(me.x); y[2] = s[2] * inv - bf_lo(me.y); y[3] = s[3] * inv - bf_hi(me.y);
    y[4] = s[4] * inv - bf_lo(me.z); y[5] = s[5] * inv - bf_hi(me.z); y[6] = s[6] * inv - bf_lo(me.w); y[7] = s[7] * inv - bf_hi(me.w);
    u32x4 o; o.x = cvt_pk_bf16(y[0], y[1]); o.y = cvt_pk_bf16(y[2], y[3]); o.z = cvt_pk_bf16(y[4], y[5]); o.w = cvt_pk_bf16(y[6], y[7]);
    *(u32x4*)(MIX + (size_t)row * D + 768 + c0) = o;
}
__device__ __forceinline__ void pool_phase(const bf16_t* U, bf16_t* MIX, int wave, int lane, int G) {
    constexpr int RB = MT / 8;
    for (int it = fresh_bx() * 8 + wave; it < 4 * RB; it += G * 8) {
        const int g = it / RB, rb = it - g * RB, row = rb * 8 + (lane >> 3), c0 = g * 64 + (lane & 7) * 8;
        if (g == 0) pool_rows<2>(U, MIX, row, c0);
        else if (g == 1) pool_rows<4>(U, MIX, row, c0);
        else if (g == 2) pool_rows<8>(U, MIX, row, c0);
        else pool_rows<16>(U, MIX, row, c0);
    }
}


#define XB_TMO      128
#define XB_XCNT(j)  (256  + 64 * (j))
#define XB_XSUB(j)  (1280 + 64 * (j))
#define XB_XGEN(j)  (2304 + 64 * (j))
#define XB_TOP      3328
#define XB_TOPGEN   3392
#define XCD_BAR_WORDS 3456
#define XB_SPIN_CAP (1u << 18)
__device__ __forceinline__ unsigned xb_ld(unsigned* p)              { return __hip_atomic_load(p, __ATOMIC_RELAXED, __HIP_MEMORY_SCOPE_AGENT); }
__device__ __forceinline__ unsigned xb_add(unsigned* p, unsigned v) { return __hip_atomic_fetch_add(p, v, __ATOMIC_RELAXED, __HIP_MEMORY_SCOPE_AGENT); }
__device__ __forceinline__ unsigned xb_xcc_id() { return (unsigned)__builtin_amdgcn_s_getreg((3 << 11) | 20) & 0xFu; }
#define XB_SPIN(cond, bar) do { unsigned _sp = 0; while (cond) { __builtin_amdgcn_s_sleep(1); \
    if ((++_sp & 255u) == 0u) { if (xb_ld(&(bar)[XB_TMO])) break; if (_sp > XB_SPIN_CAP) { atomicAdd(&(bar)[XB_TMO], 1u); break; } } } } while (0)
__device__ __forceinline__ void xcd_barrier_complete(unsigned* bar, unsigned x, unsigned G, unsigned& nloc, unsigned& nx) {
    unsigned sum, cnt, mine, sp = 0u;
    for (;;) {
        sum = 0u; cnt = 0u; mine = 0u;
#pragma unroll
        for (unsigned j = 0; j < 16; ++j) { const unsigned c = xb_ld(&bar[XB_XCNT(j)]); sum += c; cnt += (c > 0u) ? 1u : 0u; mine = (j == x) ? c : mine; }
        if (sum == G) break;
        __builtin_amdgcn_s_sleep(1);
        if ((++sp & 255u) == 0u) { if (xb_ld(&bar[XB_TMO])) break; if (sp > XB_SPIN_CAP) { atomicAdd(&bar[XB_TMO], 1u); break; } }
    }
    nloc = mine > 0u ? mine : 1u; nx = cnt > 0u ? cnt : 1u;
}
__device__ __forceinline__ void xcd_barrier(unsigned* bar, volatile LAS unsigned* st, unsigned G, bool first) {
    asm volatile("s_waitcnt vmcnt(0)" ::: "memory");
    __syncthreads();
    if (first) {
        __builtin_amdgcn_s_waitcnt(0);
        const unsigned x = xb_xcc_id();
        unsigned nloc = st[0], nx = st[1];
        if (nloc == 0u) { xcd_barrier_complete(bar, x, G, nloc, nx); st[0] = nloc; st[1] = nx; }
        const unsigned old = xb_add(&bar[XB_XSUB(x)], 1u);
        const unsigned gen = old / nloc;
        if (old + 1u == (gen + 1u) * nloc) {
            __builtin_amdgcn_fence(__ATOMIC_RELEASE, "agent");
            asm volatile("s_waitcnt vmcnt(0)" ::: "memory");
            const unsigned og = xb_add(&bar[XB_TOP], 1u);
            const unsigned tg = og / nx;
            if (og + 1u == (tg + 1u) * nx) xb_add(&bar[XB_TOPGEN], 1u);
            else XB_SPIN(xb_ld(&bar[XB_TOPGEN]) == tg, bar);
            __builtin_amdgcn_fence(__ATOMIC_ACQUIRE, "agent");
            xb_add(&bar[XB_XGEN(x)], 1u);
            asm volatile("s_waitcnt vmcnt(0)" ::: "memory");
        } else {
            XB_SPIN(xb_ld(&bar[XB_XGEN(x)]) == gen, bar);
            __builtin_amdgcn_fence(__ATOMIC_ACQUIRE, "agent");
            asm volatile("s_waitcnt vmcnt(0)" ::: "memory");
        }
    }
    __syncthreads();
}

#ifndef NSYNC
#define NSYNC 1
#endif
#define GSYNC() do { for (int s_ = 0; s_ < NSYNC; ++s_) xcd_barrier(WSP(unsigned, WS_BAR), bst, (unsigned)G, wave0 == 0 && fresh_lane() == 0); } while (0)
#define WSP(T, off) ((T*)(karg_ws() + (off)))
__global__ void __launch_bounds__(512, 2) mega_fwd(Params p) {
    extern __shared__ __attribute__((aligned(16))) unsigned char lds_raw[];
    LAS unsigned char* lds = (LAS unsigned char*)lds_raw;
    cg::grid_group grid = cg::this_grid();
    const int wave0 = __builtin_amdgcn_readfirstlane(threadIdx.x >> 6);
    int wave = wave0, lane = fresh_lane(), tid = wave * 64 + lane;
#define FRESH() do { lane = fresh_lane(); wave = wave0; tid = wave * 64 + lane; } while (0)
    constexpr int G = 256; const int bx0 = blockIdx.x; int bx = bx0;

    volatile LAS unsigned* bst = (volatile LAS unsigned*)(lds + 131072 + 64);
    if (tid == 0) { bst[0] = 0u; bst[1] = 0u; }
    if (bx == 0) { unsigned* bw = WSP(unsigned, WS_BAR); for (int i = tid; i < XCD_BAR_WORDS; i += 512) bw[i] = 0u; }
    for (int rep_ = 0; rep_ < NREP(0); ++rep_) { __syncthreads(); prologue(lds, tid, wave, lane, G); }
    grid.sync();
    if (wave0 == 0 && fresh_lane() == 0) (void)xb_add(&WSP(unsigned, WS_BAR)[XB_XCNT(xb_xcc_id())], 1u);

#pragma unroll 1
    for (int l = 0; l < 2; ++l) {
        bx = bx0; asm volatile("" : "+s"(bx));
        const bool last = (l == 1);
        const int Mx = last ? ML : MT;

        for (int rep_ = 0; rep_ < NREP(1); ++rep_) {
            FRESH();
            const float* xs_lat = l == 0 ? karg(0) : karg_out();
            if (l == 0) {
                norm_phase(xs_lat, (float*)karg(2), nullptr, karg(6) + l * D, WSP(float, WS_MOD) + (size_t)l * 9 * 6144, 0, 1024, WSP(bf16_t, WS_HX), 0, MT, wave, lane, G);
            } else {
                norm_phase(xs_lat, WSP(float, WS_H), WSP(float, WS_HX), karg(6) + l * D, WSP(float, WS_MOD) + (size_t)l * 9 * 6144, 0, 1024, WSP(bf16_t, WS_HX), ML, MT, wave, lane, G);
                GSYNC();
                FRESH();
                norm_phase(xs_lat, WSP(float, WS_H), nullptr, karg(6) + l * D, WSP(float, WS_MOD) + (size_t)l * 9 * 6144, 0, 1024, WSP(bf16_t, WS_HX), 0, ML, wave, lane, G);
            }
        }
        GSYNC();
        for (int rep_ = 0; rep_ < NREP(2); ++rep_) {
            if (RUN(13)) {
                const bf16_t* win = WSP(bf16_t, WS_WIN) + (size_t)l * 1792 * 1024;
                EpiArgs ea{}; ea.o0 = WSP(bf16_t, WS_RQ); ea.o1 = WSP(bf16_t, WS_RK); ea.o2 = WSP(bf16_t, WS_RG); ea.o3 = WSP(bf16_t, WS_CQ); ea.o4 = WSP(bf16_t, WS_U); ea.o5 = WSP(bf16_t, WS_CKV);
                ea.ssq_q = WSP(float, WS_SSQQ); ea.ssq_k = WSP(float, WS_SSQK);
                pg8::Gemm g{WSP(bf16_t, WS_HX), win, 1024, 1024, 1024}; pg8::StaticOrder S; S.init(MT, NIN, G, bx);
                Epi<EP_IN> E{ea};
                pg8::gemm_phase<Epi<EP_IN>, true>(lds, g, S, E, wave0);
            }
            if (RUN(14)) {
                const bf16_t* win = WSP(bf16_t, WS_WIN) + (size_t)l * 1792 * 1024;
                EpiArgs eb{}; eb.o0 = WSP(bf16_t, WS_RVT);
                pg8::Gemm g2{win + (size_t)1536 * 1024, WSP(bf16_t, WS_HX), 1024, 1024, 1024}; pg8::StaticOrder S2; S2.init(256, MT, G, (bx + G - 176) % G);
                Epi<EP_RVT> E2{eb};
                pg8::gemm_phase<Epi<EP_RVT>, true>(lds, g2, S2, E2, wave0);
            }
        }
        GSYNC();
        for (int rep_ = 0; rep_ < NREP(3); ++rep_) {
            if (RUN(8)) {
                EpiArgs ea{}; ea.o0 = WSP(bf16_t, WS_Q); ea.ssq_q = WSP(float, WS_SSQQ);
                pg8::Gemm g{WSP(bf16_t, WS_CQ), WSP(bf16_t, WS_WUQ) + (size_t)l * 768 * 256, 256, 256, 256}; pg8::StaticOrder S; S.init(Mx, 768, G, bx);
                Epi<EP_UPQ> E{ea};
                pg8::gemm_phase<Epi<EP_UPQ>, true>(lds, g, S, E, wave0);
            }
            if (RUN(9)) {
                EpiArgs eb{}; eb.o0 = WSP(bf16_t, WS_KN); eb.ssq_k = WSP(float, WS_SSQK);
                pg8::Gemm g2{WSP(bf16_t, WS_CKV), WSP(bf16_t, WS_WUKV) + (size_t)l * 1024 * 256, 256, 256, 256}; pg8::StaticOrder S2; S2.init(MT, 512, G, (bx + 40) % G);
                Epi<EP_UPK> E2{eb};
                pg8::gemm_phase<Epi<EP_UPK>, true>(lds, g2, S2, E2, wave0);
            }
            if (RUN(10)) {
                EpiArgs ec{}; ec.o0 = WSP(bf16_t, WS_VT); ec.ssq_k = WSP(float, WS_SSQK);
                pg8::Gemm g3{WSP(bf16_t, WS_WUKV) + (size_t)l * 1024 * 256 + (size_t)512 * 256, WSP(bf16_t, WS_CKV), 256, 256, 256}; pg8::StaticOrder S3; S3.init(512, MT, G, (bx + G - 104) % G);
                Epi<EP_VT> E3{ec};
                pg8::gemm_phase<Epi<EP_VT>, true>(lds, g3, S3, E3, wave0);
            }
            if (RUN(11)) {
                FRESH();
                const float* dl = karg(12) + l * 8;
                const int xcd = bx & 7, slot = bx >> 3;
                if (bx < 256) {
                    const int bh = xcd * 4 + (slot >> 3), qb = slot & 7, b = bh >> 2, h = bh & 3;
                    const float lf = -log1pf(expf(-dl[h])) * 1.4426950408889634f, lb = -log1pf(expf(-dl[4 + h])) * 1.4426950408889634f;
                    ret_unit(lds, WSP(bf16_t, WS_RQ), WSP(bf16_t, WS_RK), WSP(bf16_t, WS_RVT), WSP(bf16_t, WS_RG), WSP(bf16_t, WS_MIX), b, h, qb, false, lf, lb, tid, wave, lane);
                }
                if (!last && bx >= 128 && bx < 160) {
                    const int bh = bx - 128, b = bh >> 2, h = bh & 3;
                    const float lf = -log1pf(expf(-dl[h])) * 1.4426950408889634f, lb = -log1pf(expf(-dl[4 + h])) * 1.4426950408889634f;
                    ret_unit(lds, WSP(bf16_t, WS_RQ), WSP(bf16_t, WS_RK), WSP(bf16_t, WS_RVT), WSP(bf16_t, WS_RG), WSP(bf16_t, WS_MIX), b, h, 0, true, lf, lb, tid, wave, lane);
                }
            }
            if (RUN(12)) { FRESH(); pool_phase(WSP(bf16_t, WS_U), WSP(bf16_t, WS_MIX), wave, lane, G); }
        }
        GSYNC();
        for (int rep_ = 0; rep_ < NREP(4); ++rep_) {
            FRESH();
            const int xcd = bx & 7, slot = bx >> 3;
            if (bx < 256) {
#pragma unroll 1
                for (int rd = 0; rd < 2; ++rd) {
                    const int bh = rd * 32 + xcd * 4 + (slot >> 3), qb = slot & 7, b = bh >> 3, h = bh & 7;
                    attn_unit(lds, WSP(bf16_t, WS_Q), WSP(bf16_t, WS_KN), WSP(bf16_t, WS_CKV), WSP(bf16_t, WS_VT), WSP(bf16_t, WS_MIX), b, h, qb, false, tid, wave, lane);
                }
            }
            if (!last && bx < 64) attn_unit(lds, WSP(bf16_t, WS_Q), WSP(bf16_t, WS_KN), WSP(bf16_t, WS_CKV), WSP(bf16_t, WS_VT), WSP(bf16_t, WS_MIX), bx >> 3, bx & 7, 0, true, tid, wave, lane);
        }
        GSYNC();
        if (RUN(5)) {
            {
                EpiArgs ea{}; ea.xin_lat = l == 0 ? karg(0) : karg_out(); ea.xin_ctx = WSP(float, WS_H); ea.xout_lat = karg_out(); ea.xout_ctx = WSP(float, WS_H);
                ea.mod = WSP(float, WS_MOD) + (size_t)l * 9 * 6144;
                pg8::Gemm g{WSP(bf16_t, WS_MIX), WSP(bf16_t, WS_WOUT) + (size_t)l * 1024 * 1024, 1024, 1024, 1024}; pg8::StaticOrder S; S.init(ML, 1024, G, bx);
                Epi<EP_OUT> E{ea};
                pg8::gemm_phase<Epi<EP_OUT>, true>(lds, g, S, E, wave0);
            }
            if (!last) {
                const int ks = bx >> 5;
                EpiArgs ea{}; ea.xin_lat = karg_out(); ea.xin_ctx = WSP(float, WS_H); ea.xout_lat = karg_out(); ea.xout_ctx = WSP(float, WS_RQ) + (size_t)ks * MC * D;
                ea.mod = WSP(float, WS_MOD) + (size_t)l * 9 * 6144; ea.row_off = ML;
                pg8::Gemm g{WSP(bf16_t, WS_MIX) + (size_t)ML * 1024 + ks * 256, WSP(bf16_t, WS_WOUT) + (size_t)l * 1024 * 1024 + ks * 256, 1024, 1024, 256};
                pg8::StaticOrder S; S.init(MC, 1024, G, bx < 128 ? (bx & 31) : 255);
                Epi<EP_OUTA> E{ea};
                pg8::gemm_phase<Epi<EP_OUTA>, true>(lds, g, S, E, wave0);
            }
        }
        GSYNC();
        if (RUN(1)) {
            FRESH();
            norm_phase(karg_out(), WSP(float, WS_H), last ? nullptr : WSP(float, WS_RQ), karg(16) + l * D, WSP(float, WS_MOD) + (size_t)l * 9 * 6144, 3072, 4096, WSP(bf16_t, WS_HX), 0, Mx, wave, lane, G);
        }
        GSYNC();
        for (int rep_ = 0; rep_ < NREP(6); ++rep_) {
            EpiArgs ea{}; ea.o0 = WSP(bf16_t, WS_F);
            pg8::Gemm g{WSP(bf16_t, WS_HX), WSP(bf16_t, WS_WFF1) + (size_t)l * 4096 * 1024, 1024, 1024, 1024}; pg8::StaticOrder S; S.init(Mx, FF, G, bx);
            Epi<EP_FF1> E{ea};
            pg8::gemm_phase<Epi<EP_FF1>, true>(lds, g, S, E, wave0);
        }
        GSYNC();
        if (RUN(7)) {
            {
                EpiArgs ea{}; ea.xin_lat = karg_out(); ea.xin_ctx = WSP(float, WS_H); ea.xout_lat = karg_out(); ea.xout_ctx = WSP(float, WS_H);
                ea.mod = WSP(float, WS_MOD) + (size_t)l * 9 * 6144;
                pg8::Gemm g{WSP(bf16_t, WS_F), WSP(bf16_t, WS_WFF2) + (size_t)l * 1024 * 4096, 4096, 4096, 4096}; pg8::StaticOrder S; S.init(ML, 1024, G, bx);
                Epi<EP_FF2> E{ea};
                pg8::gemm_phase<Epi<EP_FF2>, true>(lds, g, S, E, wave0);
            }
            if (!last) {
                const int ks = bx >> 5;
                EpiArgs ea{}; ea.xin_lat = karg_out(); ea.xin_ctx = WSP(float, WS_H); ea.xout_lat = karg_out(); ea.xout_ctx = WSP(float, WS_HX) + (size_t)ks * MC * D;
                ea.mod = WSP(float, WS_MOD) + (size_t)l * 9 * 6144; ea.row_off = ML;
                pg8::Gemm g{WSP(bf16_t, WS_F) + (size_t)ML * 4096 + ks * 1024, WSP(bf16_t, WS_WFF2) + (size_t)l * 1024 * 4096 + ks * 1024, 4096, 4096, 1024};
                pg8::StaticOrder S; S.init(MC, 1024, G, bx < 128 ? (bx & 31) : 255);
                Epi<EP_FF2A> E{ea};
                pg8::gemm_phase<Epi<EP_FF2A>, true>(lds, g, S, E, wave0);
            }
        }
        GSYNC();
    }
    {
        FRESH();
        const float* gain = karg(19); float* outp = karg_out();
        int row = bx * 8 + wave; const int step = G * 8;
        f32x4 v[4], vn[4], vnn[4], g4[4];
#pragma unroll
        for (int j = 0; j < 4; ++j) g4[j] = *(const __attribute__((address_space(1))) f32x4*)(gain + (64 * j + lane) * 4);
#define FIN_LD(dst_, r_) do { if ((r_) < ML) { _Pragma("unroll") for (int j_ = 0; j_ < 4; ++j_) dst_[j_] = *(const __attribute__((address_space(1))) f32x4*)(outp + (size_t)(r_) * D + (64 * j_ + lane) * 4); } } while (0)
        FIN_LD(v, row); FIN_LD(vn, row + step);
        while (row < ML) {
            FIN_LD(vnn, row + 2 * step);
            float* xr = outp + (size_t)row * D;
            float ss = 0.f;
#pragma unroll
            for (int j = 0; j < 4; ++j) ss += (v[j][0] * v[j][0] + v[j][1] * v[j][1]) + (v[j][2] * v[j][2] + v[j][3] * v[j][3]);
            const float rstd = rsqrtf(wave_sum(ss) * (1.f / D) + EPS);
#pragma unroll
            for (int j = 0; j < 4; ++j) { const int c = (64 * j + lane) * 4; *(f32x4*)(xr + c) = v[j] * rstd * g4[j]; }
#pragma unroll
            for (int j = 0; j < 4; ++j) { v[j] = vn[j]; vn[j] = vnn[j]; }
            row += step;
        }
#undef FIN_LD
    }
}

extern "C" void kernel_launch(void* const* d_in, const int* in_sizes, int n_in, void* d_out, int out_size, void* d_ws, size_t ws_size, hipStream_t stream) {
    static int grid_blocks = 0;
    if (grid_blocks == 0) {
        if (n_in != 20 || ws_size < WS_END) { fprintf(stderr, "kernel_launch: unexpected inputs (n_in %d, ws %zu)\n", n_in, ws_size); grid_blocks = -1; return; }
        int dev = 0, cus = 0, per_cu = 0;
        hipGetDevice(&dev);
        hipDeviceGetAttribute(&cus, hipDeviceAttributeMultiprocessorCount, dev);
        if (hipFuncSetAttribute((const void*)mega_fwd, hipFuncAttributeMaxDynamicSharedMemorySize, LDS_BYTES) != hipSuccess) { fprintf(stderr, "kernel_launch: hipFuncSetAttribute failed\n"); grid_blocks = -1; return; }
        if (hipOccupancyMaxActiveBlocksPerMultiprocessor(&per_cu, (const void*)mega_fwd, 512, LDS_BYTES) != hipSuccess || per_cu < 1) { fprintf(stderr, "kernel_launch: occupancy query failed (%d)\n", per_cu); (void)hipGetLastError(); per_cu = 1; }
        grid_blocks = cus * (per_cu > 1 ? 1 : per_cu);
        if (grid_blocks < 256) { fprintf(stderr, "kernel_launch: needs 256 co-resident workgroups, device offers %d\n", grid_blocks); grid_blocks = -1; return; }
        grid_blocks = 256;
    }
    if (grid_blocks < 0) return;
    Params p{};
    for (int i = 0; i < 20; ++i) p.in[i] = (const float*)d_in[i];
    p.out = (float*)d_out; p.ws = (unsigned char*)d_ws;
    void* args[] = {&p};
    hipError_t e = hipLaunchCooperativeKernel((const void*)mega_fwd, dim3(grid_blocks), dim3(512), args, LDS_BYTES, stream);
    if (e != hipSuccess) fprintf(stderr, "cooperative launch failed: %s (grid %d)\n", hipGetErrorString(e), grid_blocks);
}
```
